# Optimizing an MI355X kernel written in HIP

```python
import math
import jax, jax.numpy as jnp
from jax import lax
import numpy as np

D_MODEL = 1024
BATCH = 32
SEQ = 2048
DEPTH = 1

D_MIX = D_MODEL
D_A = D_MIX // 2
D_B = D_MIX - D_A
A_GROUPS = 8
A_GROUP_DIM = D_A // A_GROUPS
CHUNK = 128
B_HEADS = 8
HEAD_DIM = D_B // B_HEADS
DILATED_BRANCHES = ((128, 1), (512, 4), (2048, 16))
ROPE_THETA = 10000.0
D_IN = 2 * D_A + 3 * D_B
N_KEYS = 128
N_EXPERTS = N_KEYS * N_KEYS
PEER_HEADS = 8
PEER_TOPK = 16
D_KEY = 256
PEER_TOKEN_BLOCK = 128
EPS = 1e-6

kernel_name = "hybrid_gmlp_dilated_attn_peer_block"


def rms_norm(x, g):
    xf = x.astype(jnp.float32)
    y = xf * lax.rsqrt(jnp.mean(xf * xf, axis=-1, keepdims=True) + EPS)
    return (y * g.astype(jnp.float32)).astype(x.dtype)


def layer_norm(x, g, b):
    xf = x.astype(jnp.float32)
    mu = jnp.mean(xf, axis=-1, keepdims=True)
    var = jnp.mean(jnp.square(xf - mu), axis=-1, keepdims=True)
    y = (xf - mu) * lax.rsqrt(var + EPS)
    return (y * g.astype(jnp.float32) + b.astype(jnp.float32)).astype(x.dtype)


def rope_tables(seq):
    pos = jnp.arange(seq, dtype=jnp.float32)
    inv = 1.0 / (ROPE_THETA ** (jnp.arange(0, HEAD_DIM, 2, dtype=jnp.float32) / HEAD_DIM))
    ang = pos[:, None] * inv[None, :]
    return jnp.cos(ang)[:, None, :], jnp.sin(ang)[:, None, :]


def apply_rope(t, cos, sin):
    tf = t.astype(jnp.float32)
    t1, t2 = tf[..., :HEAD_DIM // 2], tf[..., HEAD_DIM // 2:]
    return jnp.concatenate([t1 * cos - t2 * sin, t2 * cos + t1 * sin], axis=-1).astype(t.dtype)


def spatial_gating(u, v, ln_g, ln_b, w_s, b_s):
    B, S, _ = u.shape
    v = layer_norm(v, ln_g, ln_b)
    vc = v.reshape(B, S // CHUNK, CHUNK, A_GROUPS, A_GROUP_DIM)
    mixed = jnp.einsum('gpq,bnqgc->bnpgc', w_s, vc) + b_s.T[None, None, :, :, None]
    return u * mixed.reshape(B, S, D_A)


def to_residue(t, d):
    B, S = t.shape[:2]
    t = t.reshape((B, S // d, d) + t.shape[2:])
    t = jnp.swapaxes(t, 1, 2)
    return t.reshape((B * d, S // d) + t.shape[3:])


def from_residue(t, d, B):
    L = t.shape[1]
    t = t.reshape((B, d, L) + t.shape[2:])
    t = jnp.swapaxes(t, 1, 2)
    return t.reshape((B, L * d) + t.shape[3:])


def banded_attention(q, k, v, half_window):
    N, L, H, hd = q.shape
    blk = half_window
    nb = -(-L // blk)
    pad = nb * blk - L
    qb = jnp.pad(q, ((0, 0), (0, pad), (0, 0), (0, 0))).reshape(N, nb, blk, H, hd)
    kp = jnp.pad(k, ((0, 0), (blk, pad + blk), (0, 0), (0, 0))).reshape(N, nb + 2, blk, H, hd)
    vp = jnp.pad(v, ((0, 0), (blk, pad + blk), (0, 0), (0, 0))).reshape(N, nb + 2, blk, H, hd)
    kw = jnp.concatenate([kp[:, :-2], kp[:, 1:-1], kp[:, 2:]], axis=2)
    vw = jnp.concatenate([vp[:, :-2], vp[:, 1:-1], vp[:, 2:]], axis=2)
    s = jnp.einsum('nbqhd,nbkhd->nbhqk', qb, kw).astype(jnp.float32) * (HEAD_DIM ** -0.5)
    blocks = jnp.arange(nb)[:, None] * blk
    qpos = blocks + jnp.arange(blk)[None, :]
    kpos = blocks - blk + jnp.arange(3 * blk)[None, :]
    rel = kpos[:, None, :] - qpos[:, :, None]
    valid = (jnp.abs(rel) <= half_window) & (kpos >= 0)[:, None, :] & (kpos < L)[:, None, :]
    s = jnp.where(valid[None, :, None], s, -jnp.inf)
    m = jnp.max(s, axis=-1, keepdims=True)
    p = jnp.exp(s - m)
    l = jnp.sum(p, axis=-1)
    o = jnp.einsum('nbhqk,nbkhd->nbqhd', p, vw.astype(jnp.float32))
    l_t = jnp.swapaxes(l, 2, 3)
    o = o / l_t[..., None]
    lse = jnp.swapaxes(m[..., 0], 2, 3) + jnp.log(l_t)
    o = o.reshape(N, nb * blk, H, hd)[:, :L]
    lse = lse.reshape(N, nb * blk, H)[:, :L]
    return o, lse


def dilated_attention(q, k, v):
    B = q.shape[0]
    outs, lses = [], []
    for window, dil in DILATED_BRANCHES:
        half_window = window // (2 * dil)
        o, lse = banded_attention(to_residue(q, dil), to_residue(k, dil), to_residue(v, dil), half_window)
        outs.append(from_residue(o, dil, B))
        lses.append(from_residue(lse, dil, B))
    w = jax.nn.softmax(jnp.stack(lses, axis=0), axis=0)
    return jnp.sum(w[..., None] * jnp.stack(outs, axis=0), axis=0)


def peer(xn, w_query, sub_keys, expert_u, expert_v):
    B, S, D = xn.shape
    xt = xn.reshape((B * S) // PEER_TOKEN_BLOCK, PEER_TOKEN_BLOCK, D)

    def block(xb):
        q = (xb @ w_query).reshape(PEER_TOKEN_BLOCK, PEER_HEADS, 2, D_KEY // 2)
        s = jnp.einsum('thpc,pkc->thpk', q, sub_keys).astype(jnp.float32)
        s1, i1 = lax.top_k(s[:, :, 0], PEER_TOPK)
        s2, i2 = lax.top_k(s[:, :, 1], PEER_TOPK)
        cand = (s1[..., :, None] + s2[..., None, :]).reshape(PEER_TOKEN_BLOCK, PEER_HEADS, PEER_TOPK * PEER_TOPK)
        sc, ci = lax.top_k(cand, PEER_TOPK)
        e = (jnp.take_along_axis(i1, ci // PEER_TOPK, axis=-1) * N_KEYS
             + jnp.take_along_axis(i2, ci % PEER_TOPK, axis=-1))
        g = jax.nn.softmax(sc, axis=-1)
        u = expert_u[e]
        act = jax.nn.gelu(jnp.einsum('td,thkd->thk', xb, u).astype(jnp.float32))
        return jnp.einsum('thk,thkd->td', (g * act).astype(xb.dtype), expert_v[e])

    return lax.map(block, xt).reshape(B, S, D)


def setup_inputs(seed: int = 0) -> dict:
    key = jax.random.key(seed)
    ks = jax.random.split(key, 17)
    f32 = jnp.float32
    n = lambda k, shape: jax.random.normal(k, shape, dtype=f32)
    return {
        "x": n(ks[0], (BATCH, SEQ, D_MODEL)),
        "norm1_g": 1.0 + 0.02 * n(ks[1], (DEPTH, D_MODEL)),
        "w_in": n(ks[2], (DEPTH, D_MODEL, D_IN)) * D_MODEL ** -0.5,
        "ln_v_g": 1.0 + 0.02 * n(ks[3], (DEPTH, D_A)),
        "ln_v_b": 0.02 * n(ks[4], (DEPTH, D_A)),
        "w_spatial": n(ks[5], (DEPTH, A_GROUPS, CHUNK, CHUNK)) * CHUNK ** -0.5,
        "b_spatial": 0.02 * n(ks[6], (DEPTH, A_GROUPS, CHUNK)),
        "out_norm_a_g": 1.0 + 0.02 * n(ks[7], (DEPTH, D_A)),
        "out_norm_b_g": 1.0 + 0.02 * n(ks[8], (DEPTH, D_B)),
        "w_out": n(ks[9], (DEPTH, D_MIX, D_MODEL)) * D_MIX ** -0.5,
        "norm2_g": 1.0 + 0.02 * n(ks[10], (DEPTH, D_MODEL)),
        "w_query": n(ks[11], (DEPTH, D_MODEL, PEER_HEADS * D_KEY)) * D_MODEL ** -0.5,
        "sub_keys": n(ks[12], (DEPTH, 2, N_KEYS, D_KEY // 2)) * (D_KEY // 2) ** -0.5,
        "expert_u": n(ks[13], (DEPTH, N_EXPERTS, D_MODEL)) * D_MODEL ** -0.5,
        "expert_v": n(ks[14], (DEPTH, N_EXPERTS, D_MODEL)) * PEER_HEADS ** -0.5,
        "final_norm_g": 1.0 + 0.02 * n(ks[15], (D_MODEL,)),
    }


def reference(x, norm1_g, w_in, ln_v_g, ln_v_b, w_spatial, b_spatial, out_norm_a_g, out_norm_b_g,
              w_out, norm2_g, w_query, sub_keys, expert_u, expert_v, final_norm_g):
    B, S, _ = x.shape
    cos, sin = rope_tables(S)
    for layer in range(DEPTH):
        h = rms_norm(x, norm1_g[layer])
        proj = h @ w_in[layer]
        u_a, v_a, q, k, v = jnp.split(
            proj, [D_A, 2 * D_A, 2 * D_A + D_B, 2 * D_A + 2 * D_B], axis=-1)
        a_out = spatial_gating(jax.nn.gelu(u_a), jax.nn.gelu(v_a), ln_v_g[layer], ln_v_b[layer],
                               w_spatial[layer], b_spatial[layer])
        q = apply_rope(q.reshape(B, S, B_HEADS, HEAD_DIM), cos, sin)
        k = apply_rope(k.reshape(B, S, B_HEADS, HEAD_DIM), cos, sin)
        v = v.reshape(B, S, B_HEADS, HEAD_DIM)
        b_out = dilated_attention(q, k, v).reshape(B, S, D_B).astype(x.dtype)
        mix = jnp.concatenate([rms_norm(a_out, out_norm_a_g[layer]),
                               rms_norm(b_out, out_norm_b_g[layer])], axis=-1)
        x = x + mix @ w_out[layer]
        x = x + peer(rms_norm(x, norm2_g[layer]), w_query[layer], sub_keys[layer],
                     expert_u[layer], expert_v[layer])
    return rms_norm(x, final_norm_g)
```

```cpp
#include <hip/hip_runtime.h>
#include <hip/hip_cooperative_groups.h>
#include <cstdio>
#include <cstdint>
namespace cg = cooperative_groups;

typedef unsigned short bf16_t;
typedef short bf16x8 __attribute__((ext_vector_type(8)));
typedef short s16x4 __attribute__((ext_vector_type(4)));
typedef float f32x4 __attribute__((ext_vector_type(4)));
typedef int i32x8v __attribute__((ext_vector_type(8)));
typedef float f32x2 __attribute__((ext_vector_type(2)));
typedef unsigned u32x4 __attribute__((ext_vector_type(4)));
typedef unsigned u32x2 __attribute__((ext_vector_type(2)));
typedef int i32x4v __attribute__((ext_vector_type(4)));
typedef __bf16 bf16x2v __attribute__((ext_vector_type(2)));

constexpr int NTOK = 65536, SEQ = 2048, DM = 1024, DIN = 2560, NEXP = 16384;
constexpr float EPS = 1e-6f;
constexpr int NTHREADS = 512;
constexpr int LDS_BYTES = 143360 + 16;

constexpr size_t MB = 1024 * 1024;
constexpr size_t OFF_RT = 0;
constexpr size_t OFF_WIN = 1 * MB;
constexpr size_t OFF_WOUT = 6 * MB;
constexpr size_t OFF_WQ = 8 * MB;
constexpr size_t OFF_SK = 12 * MB;
constexpr size_t OFF_WSP = 12 * MB + 65536;
constexpr size_t OFF_EU = 13 * MB;
constexpr size_t OFF_EV = 45 * MB;
constexpr size_t OFF_SCL = 76 * MB;
constexpr size_t OFF_SCLU = 76 * MB + 262144;
constexpr size_t OFF_H = 77 * MB;
constexpr size_t OFF_MIX = 205 * MB;
constexpr size_t OFF_XN = 333 * MB;
constexpr size_t OFF_P = 461 * MB;
constexpr size_t OFF_SELE = 781 * MB;
constexpr size_t OFF_SELG = 813 * MB;
constexpr size_t OFF_XQ = OFF_H;
constexpr size_t OFF_SX = OFF_H + 64 * MB;
constexpr size_t OFF_PD = OFF_P;
constexpr size_t OFF_X2B = OFF_MIX;
constexpr size_t OFF_CQ = OFF_P + 64 * MB;
constexpr size_t OFF_SS = 845 * MB;
constexpr size_t OFF_Q = 845 * MB + 262144;
constexpr size_t OFF_RS = 845 * MB + 393216;
constexpr size_t OFF_BAR = 845 * MB + 786432;
constexpr size_t OFF_X1B = 846 * MB;
constexpr size_t OFF_X8 = OFF_XN;
constexpr size_t OFF_SA8 = OFF_XN + 64 * MB;
constexpr size_t OFF_WQ8 = 975 * MB;
constexpr size_t OFF_WIN8 = 977 * MB;
constexpr size_t OFF_WOUT8 = 980 * MB;
constexpr size_t OFF_WSC = 983 * MB;
constexpr size_t OFF_MIX8 = OFF_MIX;
constexpr size_t OFF_SAM = OFF_MIX + 64 * MB;
constexpr size_t OFF_H8 = OFF_H;
constexpr size_t OFF_SAH = OFF_H + 64 * MB;
constexpr size_t WS_NEED = 984 * MB;
constexpr size_t SLICE = (size_t)NEXP * 128;

struct Params {
  const float* x; const float* norm1_g; const float* w_in; const float* ln_v_g; const float* ln_v_b;
  const float* w_spatial; const float* b_spatial; const float* out_norm_a_g; const float* out_norm_b_g;
  const float* w_out; const float* norm2_g; const float* w_query; const float* sub_keys;
  const float* expert_u; const float* expert_v; const float* final_norm_g;
  float* out; unsigned char* ws;
};

__device__ __forceinline__ unsigned cvtpk(float lo, float hi) { unsigned r; asm volatile("v_cvt_pk_bf16_f32 %0, %1, %2" : "=v"(r) : "v"(lo), "v"(hi)); return r; }
__device__ __forceinline__ float bf_lo(unsigned w) { return __uint_as_float(w << 16); }
__device__ __forceinline__ float bf_hi(unsigned w) { return __uint_as_float(w & 0xffff0000u); }
__device__ __forceinline__ float dot2(unsigned a, unsigned b, float acc) { return __builtin_amdgcn_fdot2_f32_bf16(__builtin_bit_cast(bf16x2v, a), __builtin_bit_cast(bf16x2v, b), acc, false); }
__device__ __forceinline__ float gelu_tanh(float x) {
  const float u = x * (1.5957691216057308f + 0.07135481627260026f * x * x);
  return x * __builtin_amdgcn_rcpf(1.0f + __expf(-u));
}
template <int CTRL> __device__ __forceinline__ float dppf(float x) { return __builtin_bit_cast(float, __builtin_amdgcn_mov_dpp(__builtin_bit_cast(int, x), CTRL, 0xf, 0xf, true)); }
__device__ __forceinline__ float sum8(float s) { s += dppf<0xB1>(s); s += dppf<0x4E>(s); s += dppf<0x141>(s); return s; }
__device__ __forceinline__ float max8(float s) { s = fmaxf(s, dppf<0xB1>(s)); s = fmaxf(s, dppf<0x4E>(s)); s = fmaxf(s, dppf<0x141>(s)); return s; }
__device__ __forceinline__ float sum_x16(float v) { const auto w = __builtin_amdgcn_permlane16_swap(__float_as_uint(v), __float_as_uint(v), false, false); return __uint_as_float(w[0]) + __uint_as_float(w[1]); }
__device__ __forceinline__ float sum_x32(float v) { const auto w = __builtin_amdgcn_permlane32_swap(__float_as_uint(v), __float_as_uint(v), false, false); return __uint_as_float(w[0]) + __uint_as_float(w[1]); }
__device__ __forceinline__ float max_x16(float v) { const auto w = __builtin_amdgcn_permlane16_swap(__float_as_uint(v), __float_as_uint(v), false, false); return fmaxf(__uint_as_float(w[0]), __uint_as_float(w[1])); }
__device__ __forceinline__ float max_x32(float v) { const auto w = __builtin_amdgcn_permlane32_swap(__float_as_uint(v), __float_as_uint(v), false, false); return fmaxf(__uint_as_float(w[0]), __uint_as_float(w[1])); }
__device__ __forceinline__ float sum16(float v) { v = sum8(v); return v + dppf<0x128>(v); }
__device__ __forceinline__ float max16(float v) { v = max8(v); return fmaxf(v, dppf<0x128>(v)); }
__device__ __forceinline__ float wave_sum(float v) { return sum_x32(sum_x16(sum16(v))); }
__device__ __forceinline__ float wave_max(float v) { return max_x32(max_x16(max16(v))); }
__device__ __forceinline__ int lane_id_opaque() { int l; asm volatile("v_mbcnt_lo_u32_b32 %0, -1, 0\n\tv_mbcnt_hi_u32_b32 %0, -1, %0" : "=v"(l)); return l; }
#define THREAD_IDS const int lane = lane_id_opaque(); const int wid = __builtin_amdgcn_readfirstlane((int)(threadIdx.x >> 6)); const int tid = wid * 64 + lane; (void)tid; (void)wid;
#define WAIT_V(n) asm volatile("s_waitcnt vmcnt(%0)" ::"n"(n) : "memory")
#define WAIT_L(n) asm volatile("s_waitcnt lgkmcnt(%0)" ::"n"(n) : "memory")

__device__ __forceinline__ void convert_expert_row(const Params& p, int r, int lane) {
  unsigned char* ws = p.ws;
  const int tab = r >= NEXP, e = r - tab * NEXP;
  const float* src = (tab ? p.expert_v : p.expert_u) + (size_t)e * DM + lane * 16;
  f32x4 v[4]; float am = 0.f;
#pragma unroll
  for (int i = 0; i < 4; ++i) { v[i] = __builtin_nontemporal_load((const f32x4*)(src + 4 * i)); am = fmaxf(am, fmaxf(fmaxf(fabsf(v[i][0]), fabsf(v[i][1])), fmaxf(fabsf(v[i][2]), fabsf(v[i][3])))); }
  if (tab) {
    am = wave_max(am);
    const float qs = am > 0.f ? 6.0f / am : 1.0f, dq = am > 0.f ? am * (1.0f / 6.0f) : 1.0f;
    u32x2 w = (u32x2){0u, 0u};
#pragma unroll
    for (int i = 0; i < 4; ++i)
#pragma unroll
      for (int j = 0; j < 4; ++j) {
        const float x = v[i][j] * qs, a = fabsf(x);
        const unsigned m = a < 0.25f ? 0u : a < 0.75f ? 1u : a < 1.25f ? 2u : a < 1.75f ? 3u : a < 2.5f ? 4u : a < 3.5f ? 5u : a < 5.0f ? 6u : 7u;
        const unsigned c = m | (x < 0.f ? 8u : 0u);
        w[i >> 1] |= c << (4 * (4 * (i & 1) + j));
      }
    *(u32x2*)(ws + OFF_EV + (size_t)(lane >> 4) * SLICE + (size_t)e * 128 + (lane & 15) * 8) = w;
    if (lane == 0) ((float*)(ws + OFF_SCL))[2 * e + 1] = dq;
  } else {
    am = 0.f;
    f32x4 vg[4];
#pragma unroll
    for (int i = 0; i < 4; ++i) { vg[i] = v[i] * *(const f32x4*)(p.norm2_g + lane * 16 + 4 * i); am = fmaxf(am, fmaxf(fmaxf(fabsf(vg[i][0]), fabsf(vg[i][1])), fmaxf(fabsf(vg[i][2]), fabsf(vg[i][3])))); }
    am = max16(am);
    const float qs = am > 0.f ? 8.0f / am : 0.f, dq = am * 0.125f;
    u32x2 w = (u32x2){0u, 0u};
#pragma unroll
    for (int i = 0; i < 4; ++i)
#pragma unroll
      for (int j = 0; j < 4; ++j) {
        const int n = (int)fminf(fmaxf(floorf(vg[i][j] * qs), -8.0f), 7.0f);
        w[i >> 1] |= ((unsigned)n & 15u) << (4 * ((i & 1) ? 2 * j + 1 : 2 * j));
      }
    *(u32x2*)(ws + OFF_EU + (size_t)(lane >> 4) * SLICE + (size_t)e * 128 + (lane & 15) * 8) = w;
    if ((lane & 15) == 0) ((float*)(ws + OFF_SCLU))[4 * e + (lane >> 4)] = dq;
  }
}

__device__ void phase_prep(const Params& p, unsigned char* smem) {
  THREAD_IDS
  unsigned char* ws = p.ws;
  {
    float* T = (float*)smem;
    constexpr int T_IN = 16 * 40, T_OUT = 16 * 16, T_Q = 16 * 32;
    for (int tile = blockIdx.x; tile < T_IN + T_OUT; tile += gridDim.x) {
      const float* src; bf16_t* dst; int N, tt;
      if (tile < T_IN) { src = p.w_in; dst = (bf16_t*)(ws + OFF_WIN); N = 2560; tt = tile; }
      else if (tile < T_IN + T_OUT) { src = p.w_out; dst = (bf16_t*)(ws + OFF_WOUT); N = 1024; tt = tile - T_IN; }
      else { src = p.w_query; dst = (bf16_t*)(ws + OFF_WQ); N = 2048; tt = tile - T_IN - T_OUT; }
      const int nt = N / 64, k0 = (tt / nt) * 64, n0 = (tt % nt) * 64;
#pragma unroll
      for (int i = 0; i < 2; ++i) {
        const int r = (tid >> 4) + 32 * i, c4 = (tid & 15) * 4;
        const f32x4 v = *(const f32x4*)(src + (size_t)(k0 + r) * N + n0 + c4);
        T[r * 65 + c4 + 0] = v[0]; T[r * 65 + c4 + 1] = v[1]; T[r * 65 + c4 + 2] = v[2]; T[r * 65 + c4 + 3] = v[3];
      }
      __syncthreads();
      {
        const int n = tid >> 3, k8 = (tid & 7) * 8;
        u32x4 w;
        float gk[8];
#pragma unroll
        for (int j = 0; j < 8; ++j) gk[j] = (tile >= T_IN + T_OUT) ? p.norm2_g[k0 + k8 + j] : 1.0f;
        w[0] = cvtpk(T[(k8 + 0) * 65 + n] * gk[0], T[(k8 + 1) * 65 + n] * gk[1]); w[1] = cvtpk(T[(k8 + 2) * 65 + n] * gk[2], T[(k8 + 3) * 65 + n] * gk[3]);
        w[2] = cvtpk(T[(k8 + 4) * 65 + n] * gk[4], T[(k8 + 5) * 65 + n] * gk[5]); w[3] = cvtpk(T[(k8 + 6) * 65 + n] * gk[6], T[(k8 + 7) * 65 + n] * gk[7]);
        int nr = n0 + n;
        if (tile < T_IN) {
          if (nr >= 1024 && nr < 2048) nr = (nr & ~48) | ((nr & 16) << 1) | ((nr & 32) >> 1);
          else { const int a = nr & 31; nr = (nr & ~31) | (((a >> 2) & 1) << 4) | ((a >> 3) << 2) | (a & 3); }
        }
        *(u32x4*)(dst + (size_t)nr * 1024 + k0 + k8) = w;
      }
      __syncthreads();
    }
  }
  {
    const size_t gt = (size_t)blockIdx.x * NTHREADS + tid, gn = (size_t)gridDim.x * NTHREADS;
    const float* srcs[1] = {p.w_spatial};
    const size_t offs[1] = {OFF_WSP};
    const size_t cnts[1] = {8 * 128 * 128 / 8};
#pragma unroll
    for (int a = 0; a < 1; ++a) {
      const float* s = srcs[a]; bf16_t* d = (bf16_t*)(ws + offs[a]);
      for (size_t i = gt; i < cnts[a]; i += gn) {
        const f32x4 v0 = *(const f32x4*)(s + i * 8), v1 = *(const f32x4*)(s + i * 8 + 4);
        u32x4 w; w[0] = cvtpk(v0[0], v0[1]); w[1] = cvtpk(v0[2], v0[3]); w[2] = cvtpk(v1[0], v1[1]); w[3] = cvtpk(v1[2], v1[3]);
        *(u32x4*)(d + i * 8) = w;
      }
    }
    f32x2* RT = (f32x2*)(ws + OFF_RT);
    for (size_t i = gt; i < (size_t)SEQ * 32; i += gn) {
      const int pos = (int)(i >> 5), j = (int)(i & 31);
      const double inv = pow(10000.0, -(double)j / 32.0), ang = (double)pos * inv;
      f32x2 cs; cs[0] = (float)cos(ang); cs[1] = (float)sin(ang);
      RT[i] = cs;
    }
  }
  {
    bf16_t* WQ = (bf16_t*)(ws + OFF_WQ);
    const int fr = lane & 15, fq = lane >> 4;
    for (int tile = blockIdx.x * 8 + wid; tile < 16 * 8 * 64; tile += gridDim.x * 8) {
      const int hp = tile >> 9, kt = (tile >> 6) & 7, dt = tile & 63, pp = hp & 1;
      f32x4 acc = (f32x4){0.f, 0.f, 0.f, 0.f};
#pragma unroll
      for (int ks = 0; ks < 4; ++ks) {
        const float* ap = p.w_query + (size_t)(dt * 16 + fr) * 2048 + hp * 128 + ks * 32 + fq * 8;
        const float* bp = p.sub_keys + ((size_t)pp * 128 + kt * 16 + fr) * 128 + ks * 32 + fq * 8;
        const f32x4 a0 = *(const f32x4*)ap, a1 = *(const f32x4*)(ap + 4), b0 = *(const f32x4*)bp, b1 = *(const f32x4*)(bp + 4);
        u32x4 aw, bw;
        aw[0] = cvtpk(a0[0], a0[1]); aw[1] = cvtpk(a0[2], a0[3]); aw[2] = cvtpk(a1[0], a1[1]); aw[3] = cvtpk(a1[2], a1[3]);
        bw[0] = cvtpk(b0[0], b0[1]); bw[1] = cvtpk(b0[2], b0[3]); bw[2] = cvtpk(b1[0], b1[1]); bw[3] = cvtpk(b1[2], b1[3]);
        acc = __builtin_amdgcn_mfma_f32_16x16x32_bf16(__builtin_bit_cast(bf16x8, aw), __builtin_bit_cast(bf16x8, bw), acc, 0, 0, 0);
      }
      const f32x4 g2 = *(const f32x4*)(p.norm2_g + dt * 16 + 4 * fq);
      u32x2 w; w[0] = cvtpk(acc[0] * g2[0], acc[1] * g2[1]); w[1] = cvtpk(acc[2] * g2[2], acc[3] * g2[3]);
      *(u32x2*)(WQ + (size_t)(hp * 128 + kt * 16 + fr) * 1024 + dt * 16 + 4 * fq) = w;
    }
  }
  {
    float* SS = (float*)(ws + OFF_SS);
    for (int i = blockIdx.x * NTHREADS + tid; i < NTOK; i += gridDim.x * NTHREADS) SS[i] = 0.f;
    if (blockIdx.x == 0 && tid < 16 * 32) { ((unsigned*)(ws + OFF_Q))[tid] = 0u; ((unsigned*)(ws + OFF_Q))[512 + tid] = 0u; }
  }
  {
    f32x4 g[4];
#pragma unroll
    for (int i = 0; i < 4; ++i) g[i] = *(const f32x4*)(p.norm1_g + (i >> 1) * 512 + lane * 8 + (i & 1) * 4);
    const int rstep = gridDim.x * 8;
    f32x4 vn[4];
    { const int r0 = blockIdx.x * 8 + wid;
#pragma unroll
      for (int i = 0; i < 4; ++i) vn[i] = __builtin_nontemporal_load((const f32x4*)(p.x + (size_t)r0 * DM + (i >> 1) * 512 + lane * 8 + (i & 1) * 4)); }
    for (int row = blockIdx.x * 8 + wid; row < NTOK; row += rstep) {
      f32x4 v[4]; float ss = 0.f;
#pragma unroll
      for (int i = 0; i < 4; ++i) { v[i] = vn[i]; ss += v[i][0] * v[i][0] + v[i][1] * v[i][1] + v[i][2] * v[i][2] + v[i][3] * v[i][3]; }
      if (row + rstep < NTOK) {
#pragma unroll
        for (int i = 0; i < 4; ++i) vn[i] = __builtin_nontemporal_load((const f32x4*)(p.x + (size_t)(row + rstep) * DM + (i >> 1) * 512 + lane * 8 + (i & 1) * 4));
      }
      ss = wave_sum(ss);
      const float rs = rsqrtf(ss * (1.0f / DM) + EPS);
      float am = 0.f;
#pragma unroll
      for (int i = 0; i < 4; ++i) { v[i] = v[i] * g[i] * rs; am = fmaxf(am, fmaxf(fmaxf(fabsf(v[i][0]), fabsf(v[i][1])), fmaxf(fabsf(v[i][2]), fabsf(v[i][3])))); }
      am = wave_max(am);
      const float qs = am > 0.f ? 127.0f / am : 0.f;
#pragma unroll
      for (int hf = 0; hf < 2; ++hf) {
        u32x2 q;
#pragma unroll
        for (int e = 0; e < 2; ++e) {
          const f32x4 a = v[2 * hf + e] * qs;
          q[e] = ((unsigned)__float2int_rn(a[0]) & 0xffu) | (((unsigned)__float2int_rn(a[1]) & 0xffu) << 8) | (((unsigned)__float2int_rn(a[2]) & 0xffu) << 16) | ((unsigned)__float2int_rn(a[3]) << 24);
        }
        *(u32x2*)(ws + OFF_H8 + (size_t)row * DM + hf * 512 + lane * 8) = q;
      }
      if (lane == 0) ((float*)(ws + OFF_SAH))[row] = am * (1.0f / 127.0f);
    }
  }
}

constexpr int HTB = 128 * 64 * 2;
__device__ __forceinline__ int lds_byte(int r, int c) { const int st = (r >> 4) * 2 + (c >> 5), ob = (r & 15) * 64 + (c & 31) * 2; return st * 1024 + (ob ^ (((ob >> 9) & 1) << 5)); }
__device__ __forceinline__ void stage_rc(int b, int& R, int& C) { const int st = b >> 10, sb = b & 1023, swz = sb ^ (((sb >> 9) & 1) << 5); R = (st >> 1) * 16 + swz / 64; C = (st & 1) * 32 + (swz % 64) / 2; }
struct Unit { int pm, pn; };
struct StaticOrder {
  int nM, nN, nwg, G, c;
  __device__ void init(int M, int N, int G_, int c_) { nM = M / 256; nN = N / 256; nwg = nM * nN; G = G_; c = c_; }
  __device__ bool next(int i, Unit& u) const {
    const long L = (long)i * G + c; if (L >= nwg) return false;
    int wgid = (int)L; { const int q = nwg / 8, r = nwg % 8, xcd = wgid % 8, off = wgid / 8; wgid = (xcd < r ? xcd * (q + 1) : r * (q + 1) + (xcd - r) * q) + off; }
    const int nig = 8 * nN, gid = wgid / nig, fm = gid * 8, gsz = (nM - fm) < 8 ? (nM - fm) : 8;
    u.pm = fm + ((wgid % nig) % gsz); u.pn = (wgid % nig) / gsz; return true;
  }
};
struct OneUnit { Unit u; __device__ bool next(int i, Unit& o) const { if (i) return false; o = u; return true; } };

template <class Epi, class Sched, bool I8 = false>
__device__ __forceinline__ void gemm_phase(unsigned char* smem, const bf16_t* Ag, const bf16_t* Btg, const int K, const Sched& S, const Epi& E, const float* SA = nullptr, const float* SB = nullptr,
                                           const Unit pre_next = Unit{-1, 0}, const bool prestaged = false) {
  THREAD_IDS const int wr = wid >> 2, wc = wid & 3, fr = lane & 15, fq = lane >> 4;
  __attribute__((address_space(3))) unsigned char* lds = (__attribute__((address_space(3))) unsigned char*)smem;
  const int nt = K / 64;
  unsigned voff[2];
#pragma unroll
  for (int i = 0; i < 2; ++i) { int R, C; stage_rc(tid * 16 + i * 8192, R, C); voff[i] = (unsigned)(R * K + C) * 2u; }
  const size_t kstep = 128, hstep = (size_t)128 * K * 2, tstep = 2 * hstep;
  const unsigned ldsw = (unsigned)wid * 1024u;
  const int aoff = lds_byte(wr * 64 + fr, fq * 8), boff = lds_byte(wc * 32 + fr, fq * 8);
#define PG8_SA(b, h) (((b) * 2 + (h)) * HTB)
#define PG8_SB(b, h) ((4 + (b) * 2 + (h)) * HTB)
#define PG8_STAGE(bufoff, gbase) do { _Pragma("unroll") for (int _i = 0; _i < 2; ++_i) \
    __builtin_amdgcn_global_load_lds((const unsigned*)((const char*)(gbase) + voff[_i]), (__attribute__((address_space(3))) unsigned*)(lds + (bufoff) + ldsw + _i * 8192), 16, 0, 0); } while (0)
#define PG8_LDA(dst, b, h) do { _Pragma("unroll") for (int m = 0; m < 4; ++m) _Pragma("unroll") for (int k = 0; k < 2; ++k) dst[m][k] = *(const __attribute__((address_space(3))) bf16x8*)(lds + PG8_SA(b, h) + aoff + m * 2048 + k * 1024); } while (0)
#define PG8_LDB(dst, b, h) do { _Pragma("unroll") for (int n = 0; n < 2; ++n) _Pragma("unroll") for (int k = 0; k < 2; ++k) dst[n][k] = *(const __attribute__((address_space(3))) bf16x8*)(lds + PG8_SB(b, h) + boff + n * 2048 + k * 1024); } while (0)
#define PG8_MMA(ai, bj, At, Bt) do { __builtin_amdgcn_s_setprio(1); _Pragma("unroll") for (int m = 0; m < 4; ++m) _Pragma("unroll") for (int n = 0; n < 2; ++n) _Pragma("unroll") for (int k = 0; k < 2; ++k) \
    { if constexpr (I8) acc[ai][bj][m][n] = __builtin_bit_cast(f32x4, __builtin_amdgcn_mfma_i32_16x16x64_i8(__builtin_bit_cast(i32x4v, Bt[n][k]), __builtin_bit_cast(i32x4v, At[m][k]), __builtin_bit_cast(i32x4v, acc[ai][bj][m][n]), 0, 0, 0)); \
      else acc[ai][bj][m][n] = __builtin_amdgcn_mfma_f32_16x16x32_bf16(Bt[n][k], At[m][k], acc[ai][bj][m][n], 0, 0, 0); } __builtin_amdgcn_s_setprio(0); } while (0)
#define PG8_WAIT_V(n) asm volatile("s_waitcnt vmcnt(" #n ")" ::: "memory")
#define PG8_WAIT_L(n) asm volatile("s_waitcnt lgkmcnt(" #n ")" ::: "memory")
#define PG8_BAR __builtin_amdgcn_s_barrier()
#define PG8_SCHED __builtin_amdgcn_sched_barrier(0)
  Unit cur, nxt; int ui = 0;
  if (!S.next(0, cur)) return;
  f32x4 acc[2][2][4][2];
#pragma unroll
  for (int a = 0; a < 2; ++a)
#pragma unroll
    for (int b = 0; b < 2; ++b)
#pragma unroll
      for (int m = 0; m < 4; ++m)
#pragma unroll
        for (int n = 0; n < 2; ++n) acc[a][b][m][n] = (f32x4){0.f, 0.f, 0.f, 0.f};
  bf16x8 At[4][2], B0[2][2], B1[2][2];
  const char* cA = (const char*)Ag + (size_t)cur.pm * tstep; const char* cB = (const char*)Btg + (size_t)cur.pn * tstep;
  auto rescale = [&]() {
    float sa[2][4]; f32x4 sb[2][2];
#pragma unroll
    for (int a = 0; a < 2; ++a)
#pragma unroll
      for (int m = 0; m < 4; ++m) sa[a][m] = SA[cur.pm * 256 + a * 128 + wr * 64 + m * 16 + fr];
#pragma unroll
    for (int b = 0; b < 2; ++b)
#pragma unroll
      for (int n = 0; n < 2; ++n) sb[b][n] = *(const f32x4*)(SB + cur.pn * 256 + b * 128 + wc * 32 + n * 16 + 4 * fq);
#pragma unroll
    for (int a = 0; a < 2; ++a)
#pragma unroll
      for (int b = 0; b < 2; ++b)
#pragma unroll
        for (int m = 0; m < 4; ++m)
#pragma unroll
          for (int n = 0; n < 2; ++n) {
            const i32x4v iv = __builtin_bit_cast(i32x4v, acc[a][b][m][n]);
            acc[a][b][m][n] = (f32x4){(float)iv[0], (float)iv[1], (float)iv[2], (float)iv[3]} * sb[b][n] * sa[a][m];
          }
  };
  if (!prestaged) {
    PG8_STAGE(PG8_SB(0, 0), cB); PG8_STAGE(PG8_SA(0, 0), cA); PG8_STAGE(PG8_SB(0, 1), cB + hstep); PG8_STAGE(PG8_SA(0, 1), cA + hstep);
    if (wr == 1) PG8_BAR;
    PG8_WAIT_V(4); PG8_BAR;
    PG8_STAGE(PG8_SB(1, 0), cB + kstep); PG8_STAGE(PG8_SA(1, 0), cA + kstep); PG8_STAGE(PG8_SB(1, 1), cB + hstep + kstep);
    PG8_WAIT_V(6); PG8_BAR;
  } else {
    if (wr == 1) PG8_BAR;
    PG8_WAIT_V(0); PG8_BAR;
    PG8_BAR;
  }
  for (;;) {
    const bool has_next = S.next(ui + 1, nxt);
    const char* nA = has_next ? (const char*)Ag + (size_t)nxt.pm * tstep : cA; const char* nB = has_next ? (const char*)Btg + (size_t)nxt.pn * tstep : cB;
    for (int t = 0; t < nt; t += 2) {
      const bool last = (t == nt - 2);
      const char* a1 = cA + (size_t)(t + 1) * kstep;
      const char* a2 = last ? nA : cA + (size_t)(t + 2) * kstep; const char* b2 = last ? nB : cB + (size_t)(t + 2) * kstep;
      const char* a3 = a2 + kstep; const char* b3 = b2 + kstep;
      PG8_LDB(B0, 0, 0); PG8_SCHED; PG8_LDA(At, 0, 0); PG8_STAGE(PG8_SA(1, 1), a1 + hstep);
      PG8_WAIT_L(8); PG8_BAR; PG8_WAIT_L(0); PG8_MMA(0, 0, At, B0); PG8_BAR; PG8_SCHED;
      PG8_LDB(B1, 0, 1); PG8_STAGE(PG8_SB(0, 0), b2);
      PG8_BAR; PG8_WAIT_L(0); PG8_MMA(0, 1, At, B1); PG8_BAR;
      PG8_LDA(At, 0, 1); PG8_STAGE(PG8_SA(0, 0), a2);
      PG8_BAR; PG8_WAIT_L(0); PG8_MMA(1, 0, At, B0); PG8_BAR; PG8_SCHED;
      PG8_STAGE(PG8_SB(0, 1), b2 + hstep);
      PG8_WAIT_V(6); PG8_BAR; PG8_MMA(1, 1, At, B1); PG8_BAR;
      PG8_LDB(B0, 1, 0); PG8_SCHED; PG8_LDA(At, 1, 0); PG8_STAGE(PG8_SA(0, 1), a2 + hstep);
      PG8_WAIT_L(8); PG8_BAR; PG8_WAIT_L(0); PG8_MMA(0, 0, At, B0); PG8_BAR; PG8_SCHED;
      PG8_LDB(B1, 1, 1); PG8_STAGE(PG8_SB(1, 0), b3);
      PG8_BAR; PG8_WAIT_L(0); PG8_MMA(0, 1, At, B1); PG8_BAR;
      PG8_LDA(At, 1, 1); PG8_STAGE(PG8_SA(1, 0), a3);
      PG8_BAR; PG8_WAIT_L(0); PG8_MMA(1, 0, At, B0); PG8_BAR; PG8_SCHED;
      PG8_STAGE(PG8_SB(1, 1), b3 + hstep);
      PG8_WAIT_V(6); PG8_BAR; PG8_MMA(1, 1, At, B1); PG8_BAR;
    }
    if constexpr (!Epi::AFTER_DRAIN) E(acc, cur, wr, wc, fr, fq);
    if (!has_next) break;
#pragma unroll
    for (int a = 0; a < 2; ++a)
#pragma unroll
      for (int b = 0; b < 2; ++b)
#pragma unroll
        for (int m = 0; m < 4; ++m)
#pragma unroll
          for (int n = 0; n < 2; ++n) acc[a][b][m][n] = (f32x4){0.f, 0.f, 0.f, 0.f};
    cur = nxt; cA = nA; cB = nB; ++ui;
  }
  PG8_WAIT_V(0);
  if (wr == 0) PG8_BAR;
  PG8_BAR;
  if constexpr (Epi::AFTER_DRAIN) {
    if constexpr (I8) rescale();
    E.fused(acc, cur, wr, wc, fr, fq, smem, wid, lane, [&]() {
      if (pre_next.pm >= 0) {
        const char* pA = (const char*)Ag + (size_t)pre_next.pm * tstep; const char* pB = (const char*)Btg + (size_t)pre_next.pn * tstep;
        PG8_STAGE(PG8_SB(0, 0), pB); PG8_STAGE(PG8_SA(0, 0), pA); PG8_STAGE(PG8_SB(0, 1), pB + hstep); PG8_STAGE(PG8_SA(0, 1), pA + hstep);
        PG8_STAGE(PG8_SB(1, 0), pB + kstep); PG8_STAGE(PG8_SA(1, 0), pA + kstep); PG8_STAGE(PG8_SB(1, 1), pB + hstep + kstep);
      }
    });
  }
#undef PG8_SA
#undef PG8_SB
#undef PG8_STAGE
#undef PG8_LDA
#undef PG8_LDB
#undef PG8_MMA
#undef PG8_WAIT_V
#undef PG8_WAIT_L
#undef PG8_BAR
#undef PG8_SCHED
}

struct EpiIn {
  static constexpr bool AFTER_DRAIN = false;
  bf16_t* P; const f32x2* RT; const float* SA; const float* SB;
  __device__ __forceinline__ void operator()(f32x4 (&acc)[2][2][4][2], const Unit& u, int wr, int wc, int fr, int fq) const {
    const int kind = u.pn >> 1;
    float sa[2][4]; f32x4 sb[2][2];
#pragma unroll
    for (int ai = 0; ai < 2; ++ai)
#pragma unroll
      for (int m = 0; m < 4; ++m) sa[ai][m] = SA[u.pm * 256 + ai * 128 + wr * 64 + m * 16 + fr];
#pragma unroll
    for (int bj = 0; bj < 2; ++bj)
#pragma unroll
      for (int n = 0; n < 2; ++n) sb[bj][n] = *(const f32x4*)(SB + u.pn * 256 + bj * 128 + wc * 32 + n * 16 + 4 * fq);
    const bool rot = (kind == 2 || kind == 3);
    f32x4 rtn[2];
    auto ld_rt = [&](int ai, int m) {
      const int pos = (u.pm * 256 + ai * 128 + wr * 64 + m * 16 + fr) & (SEQ - 1);
      const f32x4* rt = (const f32x4*)(RT + pos * 32 + 16 * (wc & 1) + 4 * fq);
      rtn[0] = rt[0]; rtn[1] = rt[1];
    };
    if (rot) ld_rt(0, 0);
#pragma unroll
    for (int ai = 0; ai < 2; ++ai)
#pragma unroll
      for (int m = 0; m < 4; ++m) {
        const int row = u.pm * 256 + ai * 128 + wr * 64 + m * 16 + fr;
        const f32x4 c01 = rtn[0], c23 = rtn[1];
        if (rot && (ai * 4 + m + 1 < 8)) ld_rt((ai * 4 + m + 1) >> 2, (ai * 4 + m + 1) & 3);
#pragma unroll
        for (int bj = 0; bj < 2; ++bj)
#pragma unroll
          for (int n = 0; n < 2; ++n) {
            const i32x4v iv = __builtin_bit_cast(i32x4v, acc[ai][bj][m][n]);
            acc[ai][bj][m][n] = (f32x4){(float)iv[0], (float)iv[1], (float)iv[2], (float)iv[3]} * sb[bj][n] * sa[ai][m];
          }
        if (kind <= 1) {
#pragma unroll
          for (int bj = 0; bj < 2; ++bj) {
            f32x4 v0 = acc[ai][bj][m][0], v1 = acc[ai][bj][m][1];
#pragma unroll
            for (int r = 0; r < 4; ++r) { v0[r] = gelu_tanh(v0[r]); v1[r] = gelu_tanh(v1[r]); }
            u32x4 w; w[0] = cvtpk(v0[0], v0[1]); w[1] = cvtpk(v0[2], v0[3]); w[2] = cvtpk(v1[0], v1[1]); w[3] = cvtpk(v1[2], v1[3]);
            *(u32x4*)(P + (size_t)row * DIN + u.pn * 256 + bj * 128 + wc * 32 + 8 * fq) = w;
          }
        } else if (kind <= 3) {
          const int j0 = 16 * (wc & 1) + 4 * fq;
          const float sc = (kind == 2) ? 0.18033688011112042f : 1.0f;
          const float cs[4] = {c01[0], c01[2], c23[0], c23[2]}, sn[4] = {c01[1], c01[3], c23[1], c23[3]};
#pragma unroll
          for (int bj = 0; bj < 2; ++bj) {
            f32x4 o1, o2;
#pragma unroll
            for (int r = 0; r < 4; ++r) {
              const float t1 = acc[ai][bj][m][0][r], t2 = acc[ai][bj][m][1][r];
              o1[r] = (t1 * cs[r] - t2 * sn[r]) * sc; o2[r] = (t2 * cs[r] + t1 * sn[r]) * sc;
            }
            bf16_t* dst = P + (size_t)row * DIN + u.pn * 256 + bj * 128 + (wc >> 1) * 64 + j0;
            u32x2 w; w[0] = cvtpk(o1[0], o1[1]); w[1] = cvtpk(o1[2], o1[3]); *(u32x2*)dst = w;
            w[0] = cvtpk(o2[0], o2[1]); w[1] = cvtpk(o2[2], o2[3]); *(u32x2*)(dst + 32) = w;
          }
        } else {
#pragma unroll
          for (int bj = 0; bj < 2; ++bj) {
            const f32x4 v0 = acc[ai][bj][m][0], v1 = acc[ai][bj][m][1];
            u32x4 w; w[0] = cvtpk(v0[0], v0[1]); w[1] = cvtpk(v0[2], v0[3]); w[2] = cvtpk(v1[0], v1[1]); w[3] = cvtpk(v1[2], v1[3]);
            *(u32x4*)(P + (size_t)row * DIN + u.pn * 256 + bj * 128 + wc * 32 + 8 * fq) = w;
          }
        }
      }
  }
};

struct EpiOut {
  static constexpr bool AFTER_DRAIN = false;
  const float* x; bf16_t* x1; const float* SA; const float* SB;
  __device__ __forceinline__ void operator()(f32x4 (&acc)[2][2][4][2], const Unit& u, int wr, int wc, int fr, int fq) const {
    f32x4 sbv[2][2];
#pragma unroll
    for (int bj = 0; bj < 2; ++bj)
#pragma unroll
      for (int n = 0; n < 2; ++n) sbv[bj][n] = *(const f32x4*)(SB + u.pn * 256 + bj * 128 + wc * 32 + n * 16 + 4 * fq);
#pragma unroll
    for (int ai = 0; ai < 2; ++ai) {
      f32x4 xv[4][2][2]; float sav[4];
#pragma unroll
      for (int m = 0; m < 4; ++m) sav[m] = SA[u.pm * 256 + ai * 128 + wr * 64 + m * 16 + fr];
#pragma unroll
      for (int m = 0; m < 4; ++m) {
        const size_t o = (size_t)(u.pm * 256 + ai * 128 + wr * 64 + m * 16 + fr) * DM + u.pn * 256 + wc * 32 + 4 * fq;
#pragma unroll
        for (int bj = 0; bj < 2; ++bj)
#pragma unroll
          for (int n = 0; n < 2; ++n) xv[m][bj][n] = __builtin_nontemporal_load((const f32x4*)(x + o + bj * 128 + n * 16));
      }
#pragma unroll
      for (int m = 0; m < 4; ++m) {
        const size_t o = (size_t)(u.pm * 256 + ai * 128 + wr * 64 + m * 16 + fr) * DM + u.pn * 256 + wc * 32 + 4 * fq;
#pragma unroll
        for (int bj = 0; bj < 2; ++bj)
#pragma unroll
          for (int n = 0; n < 2; ++n) {
            const i32x4v iv = __builtin_bit_cast(i32x4v, acc[ai][bj][m][n]);
            const f32x4 v = xv[m][bj][n] + (f32x4){(float)iv[0], (float)iv[1], (float)iv[2], (float)iv[3]} * sbv[bj][n] * sav[m]; u32x2 w; w[0] = cvtpk(v[0], v[1]); w[1] = cvtpk(v[2], v[3]); *(u32x2*)(x1 + o + bj * 128 + n * 16) = w; }
      }
    }
  }
};

__device__ __forceinline__ void top16_insert(float (&t)[16], float x) {
#pragma unroll
  for (int s = 15; s >= 1; --s) t[s] = __builtin_amdgcn_fmed3f(t[s - 1], t[s], x);
  t[0] = fmaxf(t[0], x);
}
struct EpiSel {
  static constexpr bool AFTER_DRAIN = true;
  unsigned short* SELE; float* SELG; const float* RS; const Params* prm; int useq;
  __device__ __forceinline__ void select_half(const float* Srow, float (&t)[16]) const {
#pragma unroll
    for (int s = 0; s < 16; ++s) t[s] = -__builtin_inff();
#pragma unroll 4
    for (int k4 = 0; k4 < 32; ++k4) {
      const f32x4 v = *(const f32x4*)(Srow + k4 * 4);
#pragma unroll
      for (int j = 0; j < 4; ++j) top16_insert(t, __uint_as_float((__float_as_uint(v[j]) & 0xffffff80u) | (unsigned)(k4 * 4 + j)));
    }
  }
  template <class Hook> __device__ __forceinline__ void fused(f32x4 (&acc)[2][2][4][2], const Unit& u, int wr, int wc, int fr, int fq, unsigned char* smem, int wid, int lane, Hook&& stage_buffers_free) const {
    const int tid = wid * 64 + lane;
    float rsv[2][4];
#pragma unroll
    for (int ai = 0; ai < 2; ++ai)
#pragma unroll
      for (int m = 0; m < 4; ++m) rsv[ai][m] = RS[u.pm * 256 + ai * 128 + wr * 64 + m * 16 + fr];
    float* S = (float*)smem;
    float t1[16], t2[16];
#pragma unroll
    for (int p2 = 0; p2 < 2; ++p2) {
#pragma unroll
      for (int ai = 0; ai < 2; ++ai)
#pragma unroll
        for (int m = 0; m < 4; ++m)
#pragma unroll
          for (int n = 0; n < 2; ++n) *(f32x4*)(S + (ai * 128 + wr * 64 + m * 16 + fr) * 132 + wc * 32 + n * 16 + 4 * fq) = acc[ai][p2][m][n] * rsv[ai][m];
      __syncthreads();
      if (tid < 256) { if (p2 == 0) select_half(S + tid * 132, t1); else select_half(S + tid * 132, t2); }
      else {
#pragma unroll 1
        for (int j = 0; j < 2; ++j) convert_expert_row(*prm, useq * 16 + (wid - 4) * 4 + p2 * 2 + j, lane);
      }
      __syncthreads();
    }
    stage_buffers_free();
    if (tid < 256) {
      unsigned char* IX = smem + 135168 + tid * 32;
#pragma unroll
      for (int s = 0; s < 16; ++s) { IX[s] = (unsigned char)(__float_as_uint(t1[s]) & 0x7f); IX[16 + s] = (unsigned char)(__float_as_uint(t2[s]) & 0x7f); }
      float c[16];
#pragma unroll
      for (int s = 0; s < 16; ++s) c[s] = -__builtin_inff();
#pragma unroll
      for (int i = 0; i < 16; ++i)
#pragma unroll
        for (int j = 0; j < 16; ++j)
          if ((i + 1) * (j + 1) <= 16) {
            const float a = __uint_as_float(__float_as_uint(t1[i]) & 0xffffff80u), b = __uint_as_float(__float_as_uint(t2[j]) & 0xffffff80u);
            top16_insert(c, __uint_as_float((__float_as_uint(a + b) & 0xffffff00u) | (unsigned)(i * 16 + j)));
          }
      float g[16]; float gs = 0.f; int e[16];
      const float cmax = __uint_as_float(__float_as_uint(c[0]) & 0xffffff00u);
#pragma unroll
      for (int s = 0; s < 16; ++s) {
        const unsigned cb = __float_as_uint(c[s]); const int id = (int)(cb & 0xff);
        g[s] = __expf(__uint_as_float(cb & 0xffffff00u) - cmax); gs += g[s];
        e[s] = (int)IX[id >> 4] * 128 + (int)IX[16 + (id & 15)];
      }
      const float inv = 1.0f / gs;
      const size_t o = ((size_t)(u.pm * 256 + tid) * 8 + u.pn) * 16;
#pragma unroll
      for (int s4 = 0; s4 < 4; ++s4) {
        *(f32x4*)(SELG + o + s4 * 4) = (f32x4){g[s4 * 4] * inv, g[s4 * 4 + 1] * inv, g[s4 * 4 + 2] * inv, g[s4 * 4 + 3] * inv};
        *(u32x2*)(SELE + o + s4 * 4) = (u32x2){(unsigned)e[s4 * 4] | ((unsigned)e[s4 * 4 + 1] << 16), (unsigned)e[s4 * 4 + 2] | ((unsigned)e[s4 * 4 + 3] << 16)};
      }
    }
    __syncthreads();
  }
};

__device__ __forceinline__ void tr_read2(unsigned a0, unsigned a1, s16x4& r0, s16x4& r1) {
  asm volatile("ds_read_b64_tr_b16 %0, %2\n\tds_read_b64_tr_b16 %1, %3\n\ts_waitcnt lgkmcnt(0)" : "=&v"(r0), "=&v"(r1) : "v"(a0), "v"(a1) : "memory");
}
__device__ __forceinline__ void tr_read8(unsigned a0, unsigned a1, s16x4 (&r)[8]) {
  asm volatile("ds_read_b64_tr_b16 %0, %8\n\tds_read_b64_tr_b16 %1, %9\n\tds_read_b64_tr_b16 %2, %8 offset:32\n\tds_read_b64_tr_b16 %3, %9 offset:32\n\t"
               "ds_read_b64_tr_b16 %4, %8 offset:64\n\tds_read_b64_tr_b16 %5, %9 offset:64\n\tds_read_b64_tr_b16 %6, %8 offset:96\n\tds_read_b64_tr_b16 %7, %9 offset:96\n\ts_waitcnt lgkmcnt(0)"
               : "=&v"(r[0]), "=&v"(r[1]), "=&v"(r[2]), "=&v"(r[3]), "=&v"(r[4]), "=&v"(r[5]), "=&v"(r[6]), "=&v"(r[7]) : "v"(a0), "v"(a1) : "memory");
}
constexpr size_t OFF_OP01 = OFF_H;
constexpr size_t OFF_OP2 = OFF_XN;
constexpr size_t OFF_LSE = OFF_XN + 64 * MB;
__device__ void attn_phase(const Params& p, unsigned char* smem) {
  THREAD_IDS const int fr = lane & 15, fq = lane >> 4;
  const bf16_t* P = (const bf16_t*)(p.ws + OFF_P);
  float* LSE = (float*)(p.ws + OFF_LSE);
  unsigned char* Ks = smem; unsigned char* Vs = smem + 36864;
  const unsigned vbase = (unsigned)(uintptr_t)(__attribute__((address_space(3))) unsigned char*)Vs;
  constexpr int NITEM = 32 * 8 * 3 * 16;
  u32x4 kst[4], vst[4];
  bf16x8 qn0, qn1, qc0, qc1;
  auto stage_load = [&](int item) {
    const int ii = item & 15, br = (item >> 4) % 3, bh = item / 48, b = bh >> 3, h = bh & 7;
    const int d = br == 0 ? 16 : (br == 1 ? 4 : 1), Lb = 2048 / d;
    const int r = br == 0 ? ii : (br == 1 ? (ii & 3) : 0), qb = br == 0 ? 0 : (br == 1 ? (ii >> 2) : ii);
    const int kbase = 128 * qb - 64;
#pragma unroll
    for (int i = 0; i < 4; ++i) {
      const int c = tid + 512 * i, j = c >> 3, part = c & 7;
      int kp = kbase + j; kp = kp < 0 ? 0 : (kp > Lb - 1 ? Lb - 1 : kp);
      const bf16_t* src = P + ((size_t)b * SEQ + r + d * kp) * DIN + h * 64 + part * 8;
      kst[i] = *(const u32x4*)(src + 1536); vst[i] = *(const u32x4*)(src + 2048);
    }
    const size_t tokq = (size_t)b * SEQ + r + d * (128 * qb + 16 * wid + fr);
    qn0 = *(const bf16x8*)(P + tokq * DIN + 1024 + h * 64 + 8 * fq); qn1 = *(const bf16x8*)(P + tokq * DIN + 1024 + h * 64 + 32 + 8 * fq);
  };
  auto stage_write = [&]() {
#pragma unroll
    for (int i = 0; i < 4; ++i) {
      const int c = tid + 512 * i, j = c >> 3, part = c & 7;
      *(u32x4*)(Ks + j * 144 + part * 16) = kst[i]; *(u32x4*)(Vs + j * 160 + part * 16) = vst[i];
    }
  };
  int item = blockIdx.x;
  __syncthreads();
  if (item < NITEM) { stage_load(item); stage_write(); }
  qc0 = qn0; qc1 = qn1;
  __syncthreads();
  for (; item < NITEM; item += gridDim.x) {
    const int nxt = item + gridDim.x;
    if (nxt < NITEM) stage_load(nxt);
    {
      const int ii = item & 15, br = (item >> 4) % 3, bh = item / 48, b = bh >> 3, h = bh & 7;
      const int d = br == 0 ? 16 : (br == 1 ? 4 : 1), Lb = 2048 / d;
      const int r = br == 0 ? ii : (br == 1 ? (ii & 3) : 0), qb = br == 0 ? 0 : (br == 1 ? (ii >> 2) : ii);
      const int qpos = 128 * qb + 16 * wid + fr;
      const size_t tokq = (size_t)b * SEQ + r + d * qpos;
      const bf16x8 qf0 = qc0, qf1 = qc1;
      const int kt0 = 8 * qb - 4 + wid;
      f32x4 S[10];
#pragma unroll
      for (int T = 0; T < 10; ++T) {
        const bool live = (T < 9) && (kt0 + T >= 0) && (16 * (kt0 + T) < Lb);
        if (live) {
          const int ti = (wid + T) < 15 ? (wid + T) : 15;
          const unsigned char* kr = Ks + (16 * ti + fr) * 144 + fq * 16;
          const bf16x8 k0 = *(const bf16x8*)kr, k1 = *(const bf16x8*)(kr + 64);
          S[T] = __builtin_amdgcn_mfma_f32_16x16x32_bf16(k0, qf0, (f32x4){0.f, 0.f, 0.f, 0.f}, 0, 0, 0);
          S[T] = __builtin_amdgcn_mfma_f32_16x16x32_bf16(k1, qf1, S[T], 0, 0, 0);
        } else S[T] = (f32x4){-1e30f, -1e30f, -1e30f, -1e30f};
      }
      float mx = -1e30f;
#pragma unroll
      for (int rg = 0; rg < 4; ++rg) {
        S[0][rg] = (4 * fq + rg - fr >= 0) ? S[0][rg] : -1e30f;
        S[8][rg] = (4 * fq + rg - fr <= 0) ? S[8][rg] : -1e30f;
      }
#pragma unroll
      for (int T = 0; T < 9; ++T)
#pragma unroll
        for (int rg = 0; rg < 4; ++rg) mx = fmaxf(mx, S[T][rg]);
      mx = max_x32(max_x16(mx));
      float l = 0.f;
#pragma unroll
      for (int T = 0; T < 10; ++T)
#pragma unroll
        for (int rg = 0; rg < 4; ++rg) { S[T][rg] = __builtin_amdgcn_exp2f(S[T][rg] - mx); l += S[T][rg]; }
      l = sum_x32(sum_x16(l));
      f32x4 O[4];
#pragma unroll
      for (int dt = 0; dt < 4; ++dt) O[dt] = (f32x4){0.f, 0.f, 0.f, 0.f};
#pragma unroll
      for (int pr = 0; pr < 5; ++pr) {
        const int T0 = 2 * pr, T1 = 2 * pr + 1;
        const bool live0 = (kt0 + T0 >= 0) && (16 * (kt0 + T0) < Lb), live1 = (T1 < 9) && (kt0 + T1 >= 0) && (16 * (kt0 + T1) < Lb);
        if (!(live0 || live1)) continue;
        const int t0i = (wid + T0) < 15 ? (wid + T0) : 15, t1i = (wid + T1) < 15 ? (wid + T1) : 15;
        u32x4 pw; pw[0] = cvtpk(S[T0][0], S[T0][1]); pw[1] = cvtpk(S[T0][2], S[T0][3]); pw[2] = cvtpk(S[T1][0], S[T1][1]); pw[3] = cvtpk(S[T1][2], S[T1][3]);
        const bf16x8 pf = __builtin_bit_cast(bf16x8, pw);
        const unsigned a0 = vbase + (16 * t0i + 4 * fq + (fr >> 2)) * 160 + 4 * (fr & 3) * 2;
        const unsigned a1 = vbase + (16 * t1i + 4 * fq + (fr >> 2)) * 160 + 4 * (fr & 3) * 2;
        s16x4 vr[8]; tr_read8(a0, a1, vr);
#pragma unroll
        for (int dt = 0; dt < 4; ++dt) {
          const s16x4 v0 = vr[2 * dt], v1 = vr[2 * dt + 1];
          bf16x8 vf; vf[0] = v0[0]; vf[1] = v0[1]; vf[2] = v0[2]; vf[3] = v0[3]; vf[4] = v1[0]; vf[5] = v1[1]; vf[6] = v1[2]; vf[7] = v1[3];
          O[dt] = __builtin_amdgcn_mfma_f32_16x16x32_bf16(vf, pf, O[dt], 0, 0, 0);
        }
      }
      const float inv = 1.0f / l;
      bf16_t* op = (br < 2 ? (bf16_t*)(p.ws + OFF_OP01) + (size_t)br * NTOK * 512 : (bf16_t*)(p.ws + OFF_OP2)) + tokq * 512 + h * 64 + 4 * fq;
#pragma unroll
      for (int dt = 0; dt < 4; ++dt) {
        const f32x4 o = O[dt] * inv;
        u32x2 w; w[0] = cvtpk(o[0], o[1]); w[1] = cvtpk(o[2], o[3]);
        *(u32x2*)(op + 16 * dt) = w;
      }
      if (fq == 0) LSE[((size_t)br * NTOK + tokq) * 8 + h] = mx + __builtin_amdgcn_logf(l);
    }
    __syncthreads();
    if (nxt < NITEM) stage_write();
    qc0 = qn0; qc1 = qn1;
    __syncthreads();
  }
}

__device__ void attn_merge_phase(const Params& p) {
  THREAD_IDS
  const float* LSE = (const float*)(p.ws + OFF_LSE);
  bf16_t* MIX = (bf16_t*)(p.ws + OFF_MIX);
  const f32x4 g0 = *(const f32x4*)(p.out_norm_b_g + lane * 8), g1 = *(const f32x4*)(p.out_norm_b_g + lane * 8 + 4);
  const int h = lane >> 3, tstep = gridDim.x * 8;
  float ln[3], scn; u32x4 an, bn, cn;
  auto ld = [&](int t) {
    ln[0] = LSE[((size_t)0 * NTOK + t) * 8 + h]; ln[1] = LSE[((size_t)1 * NTOK + t) * 8 + h]; ln[2] = LSE[((size_t)2 * NTOK + t) * 8 + h];
    an = *(const u32x4*)((const bf16_t*)(p.ws + OFF_OP01) + (size_t)t * 512 + lane * 8);
    bn = *(const u32x4*)((const bf16_t*)(p.ws + OFF_OP01) + ((size_t)NTOK + t) * 512 + lane * 8);
    cn = *(const u32x4*)((const bf16_t*)(p.ws + OFF_OP2) + (size_t)t * 512 + lane * 8);
    scn = ((const float*)(p.ws + OFF_SAM))[t];
  };
  ld(blockIdx.x * 8 + wid);
  for (int t = blockIdx.x * 8 + wid; t < NTOK; t += tstep) {
    const float l0 = ln[0], l1 = ln[1], l2 = ln[2];
    const u32x4 a = an, b = bn, c = cn; const float scale = scn;
    if (t + tstep < NTOK) ld(t + tstep);
    const float mx = fmaxf(l0, fmaxf(l1, l2));
    float w0 = __builtin_amdgcn_exp2f(l0 - mx), w1 = __builtin_amdgcn_exp2f(l1 - mx), w2 = __builtin_amdgcn_exp2f(l2 - mx);
    const float inv = 1.0f / (w0 + w1 + w2); w0 *= inv; w1 *= inv; w2 *= inv;
    float o[8]; float ss = 0.f;
#pragma unroll
    for (int j = 0; j < 4; ++j) {
      o[2 * j] = w0 * bf_lo(a[j]) + w1 * bf_lo(b[j]) + w2 * bf_lo(c[j]);
      o[2 * j + 1] = w0 * bf_hi(a[j]) + w1 * bf_hi(b[j]) + w2 * bf_hi(c[j]);
      ss += o[2 * j] * o[2 * j] + o[2 * j + 1] * o[2 * j + 1];
    }
    ss = wave_sum(ss);
    const float rs = rsqrtf(ss * (1.0f / 512.0f) + EPS);
    const float qs = scale > 0.f ? 1.0f / scale : 0.f;
    float vb[8];
#pragma unroll
    for (int j = 0; j < 8; ++j) vb[j] = fminf(fmaxf(o[j] * rs * (j < 4 ? g0[j & 3] : g1[j & 3]) * qs, -127.0f), 127.0f);
    u32x2 qb;
#pragma unroll
    for (int e = 0; e < 2; ++e)
      qb[e] = ((unsigned)__float2int_rn(vb[4 * e]) & 0xffu) | (((unsigned)__float2int_rn(vb[4 * e + 1]) & 0xffu) << 8) | (((unsigned)__float2int_rn(vb[4 * e + 2]) & 0xffu) << 16) | ((unsigned)__float2int_rn(vb[4 * e + 3]) << 24);
    *(u32x2*)(p.ws + OFF_MIX8 + (size_t)t * DM + 512 + lane * 8) = qb;
  }
}

__device__ __forceinline__ void tr_read8s(unsigned a0, s16x4 (&r)[8]) {
  asm volatile("ds_read_b64_tr_b16 %0, %8\n\tds_read_b64_tr_b16 %1, %8 offset:4224\n\tds_read_b64_tr_b16 %2, %8 offset:32\n\tds_read_b64_tr_b16 %3, %8 offset:4256\n\t"
               "ds_read_b64_tr_b16 %4, %8 offset:64\n\tds_read_b64_tr_b16 %5, %8 offset:4288\n\tds_read_b64_tr_b16 %6, %8 offset:96\n\tds_read_b64_tr_b16 %7, %8 offset:4320\n\ts_waitcnt lgkmcnt(0)"
               : "=&v"(r[0]), "=&v"(r[1]), "=&v"(r[2]), "=&v"(r[3]), "=&v"(r[4]), "=&v"(r[5]), "=&v"(r[6]), "=&v"(r[7]) : "v"(a0) : "memory");
}
__device__ void spatial_item(const Params& p, int item, unsigned char* smem) {
  THREAD_IDS const int fr = lane & 15, fq = lane >> 4;
  const bf16_t* P = (const bf16_t*)(p.ws + OFF_P);
  const bf16_t* WSP = (const bf16_t*)(p.ws + OFF_WSP);
  bf16_t* MIX = (bf16_t*)(p.ws + OFF_MIX);
  const size_t t0 = (size_t)item * 128;
  constexpr int YS = 1056;
  const unsigned ybase = (unsigned)(uintptr_t)(__attribute__((address_space(3))) unsigned char*)smem;
  __syncthreads();
  {
    const f32x4 g0 = *(const f32x4*)(p.ln_v_g + lane * 8), g1 = *(const f32x4*)(p.ln_v_g + lane * 8 + 4);
    const f32x4 b0 = *(const f32x4*)(p.ln_v_b + lane * 8), b1 = *(const f32x4*)(p.ln_v_b + lane * 8 + 4);
    for (int r4 = 0; r4 < 4; ++r4) {
      u32x4 w[4];
#pragma unroll
      for (int q = 0; q < 4; ++q) w[q] = *(const u32x4*)(P + (t0 + wid * 16 + r4 * 4 + q) * DIN + 512 + lane * 8);
      float v[4][8], s1[4], s2[4];
#pragma unroll
      for (int q = 0; q < 4; ++q) {
        s1[q] = 0.f; s2[q] = 0.f;
#pragma unroll
        for (int j = 0; j < 4; ++j) { v[q][2 * j] = bf_lo(w[q][j]); v[q][2 * j + 1] = bf_hi(w[q][j]); }
#pragma unroll
        for (int i = 0; i < 8; ++i) { s1[q] += v[q][i]; s2[q] += v[q][i] * v[q][i]; }
      }
#pragma unroll
      for (int q = 0; q < 4; ++q) { s1[q] = wave_sum(s1[q]); s2[q] = wave_sum(s2[q]); }
#pragma unroll
      for (int q = 0; q < 4; ++q) {
        const float mean = s1[q] * (1.0f / 512.0f), var = fmaxf(s2[q] * (1.0f / 512.0f) - mean * mean, 0.f), rs = rsqrtf(var + EPS);
        u32x4 o;
        o[0] = cvtpk((v[q][0] - mean) * rs * g0[0] + b0[0], (v[q][1] - mean) * rs * g0[1] + b0[1]); o[1] = cvtpk((v[q][2] - mean) * rs * g0[2] + b0[2], (v[q][3] - mean) * rs * g0[3] + b0[3]);
        o[2] = cvtpk((v[q][4] - mean) * rs * g1[0] + b1[0], (v[q][5] - mean) * rs * g1[1] + b1[1]); o[3] = cvtpk((v[q][6] - mean) * rs * g1[2] + b1[2], (v[q][7] - mean) * rs * g1[3] + b1[3]);
        *(u32x4*)(smem + (wid * 16 + r4 * 4 + q) * YS + lane * 16) = o;
      }
    }
  }
  __syncthreads();
  const size_t tp = t0 + wid * 16 + fr;
  float ss = 0.f;
  unsigned keep[8][4][2];
#pragma unroll
  for (int g = 0; g < 8; ++g) {
    bf16x8 bfr[4];
#pragma unroll
    for (int ks = 0; ks < 4; ++ks) bfr[ks] = *(const bf16x8*)(WSP + (size_t)(g * 128 + wid * 16 + fr) * 128 + 32 * ks + 8 * fq);
    const float bias = p.b_spatial[g * 128 + wid * 16 + fr];
    u32x2 uw[4];
#pragma unroll
    for (int ct = 0; ct < 4; ++ct) uw[ct] = *(const u32x2*)(P + tp * DIN + 64 * g + 16 * ct + 4 * fq);
    f32x4 acc[4];
#pragma unroll
    for (int ct = 0; ct < 4; ++ct) acc[ct] = (f32x4){0.f, 0.f, 0.f, 0.f};
#pragma unroll
    for (int ks = 0; ks < 4; ++ks) {
      const unsigned a0 = ybase + (32 * ks + 8 * fq + (fr >> 2)) * YS + (64 * g + 4 * (fr & 3)) * 2;
      s16x4 vr[8]; tr_read8s(a0, vr);
#pragma unroll
      for (int ct = 0; ct < 4; ++ct) {
        const s16x4 v0 = vr[2 * ct], v1 = vr[2 * ct + 1];
        bf16x8 af; af[0] = v0[0]; af[1] = v0[1]; af[2] = v0[2]; af[3] = v0[3]; af[4] = v1[0]; af[5] = v1[1]; af[6] = v1[2]; af[7] = v1[3];
        acc[ct] = __builtin_amdgcn_mfma_f32_16x16x32_bf16(af, bfr[ks], acc[ct], 0, 0, 0);
      }
    }
#pragma unroll
    for (int ct = 0; ct < 4; ++ct) {
      f32x4 a;
      a[0] = bf_lo(uw[ct][0]) * (acc[ct][0] + bias); a[1] = bf_hi(uw[ct][0]) * (acc[ct][1] + bias); a[2] = bf_lo(uw[ct][1]) * (acc[ct][2] + bias); a[3] = bf_hi(uw[ct][1]) * (acc[ct][3] + bias);
      ss += a[0] * a[0] + a[1] * a[1] + a[2] * a[2] + a[3] * a[3];
      keep[g][ct][0] = cvtpk(a[0], a[1]); keep[g][ct][1] = cvtpk(a[2], a[3]);
    }
  }
  ss = sum_x32(sum_x16(ss));
  const float rs = rsqrtf(ss * (1.0f / 512.0f) + EPS);
  float am = 0.f;
#pragma unroll
  for (int g = 0; g < 8; ++g)
#pragma unroll
    for (int ct = 0; ct < 4; ++ct) {
      const f32x4 gm = *(const f32x4*)(p.out_norm_a_g + 64 * g + 16 * ct + 4 * fq);
      am = fmaxf(am, fmaxf(fmaxf(fabsf(bf_lo(keep[g][ct][0]) * gm[0]), fabsf(bf_hi(keep[g][ct][0]) * gm[1])), fmaxf(fabsf(bf_lo(keep[g][ct][1]) * gm[2]), fabsf(bf_hi(keep[g][ct][1]) * gm[3]))));
    }
  am = max_x32(max_x16(am)) * rs;
  float gbm = 0.f;
  { const f32x4 b0 = *(const f32x4*)(p.out_norm_b_g + lane * 8), b1 = *(const f32x4*)(p.out_norm_b_g + lane * 8 + 4);
    gbm = wave_max(fmaxf(fmaxf(fmaxf(fabsf(b0[0]), fabsf(b0[1])), fmaxf(fabsf(b0[2]), fabsf(b0[3]))), fmaxf(fmaxf(fabsf(b1[0]), fabsf(b1[1])), fmaxf(fabsf(b1[2]), fabsf(b1[3]))))); }
  const float top = fmaxf(am, 4.0f * gbm), qs = top > 0.f ? 127.0f / top : 0.f;
  if (fq == 0) ((float*)(p.ws + OFF_SAM))[tp] = top * (1.0f / 127.0f);
#pragma unroll
  for (int g = 0; g < 8; ++g)
#pragma unroll
    for (int ct = 0; ct < 4; ++ct) {
      const int ch = 64 * g + 16 * ct + 4 * fq;
      const f32x4 gm = *(const f32x4*)(p.out_norm_a_g + ch);
      const float sc = rs * qs;
      const unsigned q = ((unsigned)__float2int_rn(bf_lo(keep[g][ct][0]) * gm[0] * sc) & 0xffu) | (((unsigned)__float2int_rn(bf_hi(keep[g][ct][0]) * gm[1] * sc) & 0xffu) << 8)
                       | (((unsigned)__float2int_rn(bf_lo(keep[g][ct][1]) * gm[2] * sc) & 0xffu) << 16) | ((unsigned)__float2int_rn(bf_hi(keep[g][ct][1]) * gm[3] * sc) << 24);
      *(unsigned*)(p.ws + OFF_MIX8 + tp * DM + ch) = q;
    }
  __syncthreads();
}

template <int NCH> __device__ void quant_weight_rows(const bf16_t* W, unsigned char* W8, float* SC, int N) {
  THREAD_IDS
  for (int r = blockIdx.x * 8 + wid; r < N; r += gridDim.x * 8) {
    u32x4 w[NCH]; float am = 0.f;
#pragma unroll
    for (int c = 0; c < NCH; ++c) {
      w[c] = *(const u32x4*)(W + (size_t)r * (512 * NCH) + c * 512 + lane * 8);
#pragma unroll
      for (int j = 0; j < 4; ++j) am = fmaxf(am, fmaxf(fabsf(bf_lo(w[c][j])), fabsf(bf_hi(w[c][j]))));
    }
    am = wave_max(am);
    const float qs = am > 0.f ? 127.0f / am : 0.f;
#pragma unroll
    for (int c = 0; c < NCH; ++c) {
      u32x2 q;
#pragma unroll
      for (int e = 0; e < 2; ++e)
        q[e] = ((unsigned)__float2int_rn(bf_lo(w[c][2 * e]) * qs) & 0xffu) | (((unsigned)__float2int_rn(bf_hi(w[c][2 * e]) * qs) & 0xffu) << 8) | (((unsigned)__float2int_rn(bf_lo(w[c][2 * e + 1]) * qs) & 0xffu) << 16) | ((unsigned)__float2int_rn(bf_hi(w[c][2 * e + 1]) * qs) << 24);
      *(u32x2*)(W8 + (size_t)r * (512 * NCH) + c * 512 + lane * 8) = q;
    }
    if (lane == 0) SC[r] = am * (1.0f / 127.0f);
  }
}

__device__ void phase_xn(const Params& p) {
  THREAD_IDS
  float* RS = (float*)(p.ws + OFF_RS);
  float* SX = (float*)(p.ws + OFF_SX);
  const int rstep = gridDim.x * 8;
  u32x4 wn[2];
  { const bf16_t* xr = (const bf16_t*)(p.ws + OFF_X1B) + (size_t)(blockIdx.x * 8 + wid) * DM; wn[0] = *(const u32x4*)(xr + lane * 8); wn[1] = *(const u32x4*)(xr + 512 + lane * 8); }
  for (int row = blockIdx.x * 8 + wid; row < NTOK; row += rstep) {
    f32x4 v[4]; float ss = 0.f;
    const u32x4 wc2[2] = {wn[0], wn[1]};
    if (row + rstep < NTOK) { const bf16_t* xr = (const bf16_t*)(p.ws + OFF_X1B) + (size_t)(row + rstep) * DM; wn[0] = *(const u32x4*)(xr + lane * 8); wn[1] = *(const u32x4*)(xr + 512 + lane * 8); }
#pragma unroll
    for (int hf = 0; hf < 2; ++hf) {
      const u32x4 w = wc2[hf];
      v[2 * hf] = (f32x4){bf_lo(w[0]), bf_hi(w[0]), bf_lo(w[1]), bf_hi(w[1])}; v[2 * hf + 1] = (f32x4){bf_lo(w[2]), bf_hi(w[2]), bf_lo(w[3]), bf_hi(w[3])};
    }
#pragma unroll
    for (int i = 0; i < 4; ++i) ss += v[i][0] * v[i][0] + v[i][1] * v[i][1] + v[i][2] * v[i][2] + v[i][3] * v[i][3];
    ss = wave_sum(ss);
    const float rs = rsqrtf(ss * (1.0f / DM) + EPS);
    if (lane == 0) RS[row] = rs;
    {
      float am = 0.f;
#pragma unroll
      for (int i = 0; i < 4; ++i) am = fmaxf(am, fmaxf(fmaxf(fabsf(v[i][0]), fabsf(v[i][1])), fmaxf(fabsf(v[i][2]), fabsf(v[i][3]))));
      am = wave_max(am);
      const float qs = am > 0.f ? 119.0f / am : 0.f, sx = am * (1.0f / 119.0f) * rs;
#pragma unroll
      for (int hf = 0; hf < 2; ++hf) {
        u32x2 q; int qsum = 0;
#pragma unroll
        for (int e = 0; e < 2; ++e) {
          const f32x4 a = v[2 * hf + e] * qs;
          const int q0 = __float2int_rn(a[0]), q1 = __float2int_rn(a[1]), q2 = __float2int_rn(a[2]), q3 = __float2int_rn(a[3]);
          qsum += q0 + q1 + q2 + q3;
          q[e] = ((unsigned)q0 & 0xffu) | (((unsigned)q1 & 0xffu) << 8) | (((unsigned)q2 & 0xffu) << 16) | ((unsigned)q3 << 24);
        }
        *(u32x2*)(p.ws + OFF_X8 + (size_t)row * DM + hf * 512 + lane * 8) = q;
        const float cs = sum_x16(sum16((float)qsum));
        if ((lane & 31) == 0) *(f32x2*)(SX + ((size_t)row * 4 + 2 * hf + (lane >> 5)) * 2) = (f32x2){sx, 0.5f * sx * cs};
      }
      if (lane == 0) ((float*)(p.ws + OFF_SA8))[row] = am * (1.0f / 119.0f);
    }
  }
}

__device__ __forceinline__ unsigned xcc_id() { return (unsigned)__builtin_amdgcn_s_getreg((3 << 11) | 20) & 7u; }
constexpr int ITEM_TOK = 16;
template <int NP, class F> __device__ __forceinline__ void run_queue(unsigned* qbase, F&& body) {
  THREAD_IDS
  const int myp = (int)xcc_id() & (NP - 1);
  int k = 0;
  unsigned idx = 0;
  if (lane == 0) idx = __hip_atomic_fetch_add(qbase + myp * 32, 1u, __ATOMIC_RELAXED, __HIP_MEMORY_SCOPE_AGENT);
  while (k < NP) {
    const int part = (myp + k) & (NP - 1);
    const unsigned cur = (unsigned)__builtin_amdgcn_readfirstlane((int)idx);
    if (cur >= (unsigned)(NTOK / ITEM_TOK)) {
      ++k;
      if (k < NP && lane == 0) idx = __hip_atomic_fetch_add(qbase + ((myp + k) & (NP - 1)) * 32, 1u, __ATOMIC_RELAXED, __HIP_MEMORY_SCOPE_AGENT);
      continue;
    }
    if (lane == 0) idx = __hip_atomic_fetch_add(qbase + part * 32, 1u, __ATOMIC_RELAXED, __HIP_MEMORY_SCOPE_AGENT);
    body(part, (int)cur);
  }
}

template <int CTRL> __device__ __forceinline__ int dppi(int x) { return __builtin_amdgcn_mov_dpp(x, CTRL, 0xf, 0xf, true); }
__device__ __forceinline__ int isum8(int s) { s += dppi<0xB1>(s); s += dppi<0x4E>(s); s += dppi<0x141>(s); return s; }
__device__ void phase_udot(const Params& p, int qoff) {
  THREAD_IDS const int g = lane >> 3, sub = lane & 7;
  const unsigned char* XQ = p.ws + OFF_X8;
  const f32x2* SX = (const f32x2*)(p.ws + OFF_SX);
  const unsigned short* SELE = (const unsigned short*)(p.ws + OFF_SELE);
  unsigned* PD = (unsigned*)(p.ws + OFF_PD);
  run_queue<4>((unsigned*)(p.ws + OFF_Q) + qoff, [&](int part, int idx) {
    const unsigned char* EU = p.ws + OFF_EU + (size_t)part * SLICE + sub * 16;
    const int t0 = idx * ITEM_TOK;
    u32x4 ev[3][2], xb0[2], xb1[2], rw[2][16]; f32x2 sxv[2];
    auto ld_e = [&](int tt) {
#pragma unroll
      for (int i = 0; i < 2; ++i) ev[tt % 3][i] = *(const u32x4*)(SELE + (size_t)(t0 + tt) * 128 + g * 16 + 8 * i);
    };
    auto ld_x = [&](int tt) {
      const unsigned char* xr = XQ + (size_t)(t0 + tt) * DM + part * 256 + sub * 32;
      xb0[tt & 1] = *(const u32x4*)xr; xb1[tt & 1] = *(const u32x4*)(xr + 16);
      sxv[tt & 1] = SX[(size_t)(t0 + tt) * 4 + part];
    };
    auto ld_rows = [&](int tt) {
#pragma unroll
      for (int b = 0; b < 16; ++b) rw[tt & 1][b] = *(const u32x4*)(EU + (size_t)((ev[tt % 3][b >> 3][(b >> 1) & 3] >> (16 * (b & 1))) & 0xffffu) * 128);
    };
    auto reduce = [&](int tt) {
      unsigned xh[4], xl[4];
#pragma unroll
      for (int j = 0; j < 4; ++j) {
        const unsigned w0 = j < 2 ? xb0[tt & 1][2 * j] : xb1[tt & 1][2 * j - 4], w1 = j < 2 ? xb0[tt & 1][2 * j + 1] : xb1[tt & 1][2 * j - 3];
        const unsigned v0 = ((w0 ^ 0x80808080u) + 0x08080808u) ^ 0x88888888u, v1 = ((w1 ^ 0x80808080u) + 0x08080808u) ^ 0x88888888u;
        xl[j] = (v0 & 0x0f0f0f0fu) | ((v1 & 0x0f0f0f0fu) << 4);
        xh[j] = ((v0 >> 4) & 0x0f0f0f0fu) | (v1 & 0xf0f0f0f0u);
      }
      int k0 = 0, k1 = 0;
#pragma unroll
      for (int b = 0; b < 16; ++b) {
        int dh = 0, dl = 0;
#pragma unroll
        for (int j = 0; j < 4; ++j) { dh = __builtin_amdgcn_sdot8((int)rw[tt & 1][b][j], (int)xh[j], dh, false); dl = __builtin_amdgcn_sdot8((int)rw[tt & 1][b][j], (int)xl[j], dl, false); }
        const int d = isum8(dh * 16 + dl);
        if (b & 1) k1 = (sub == (b >> 1)) ? d : k1; else k0 = (sub == (b >> 1)) ? d : k0;
      }
      PD[((size_t)(t0 + tt) * 4 + part) * 64 + g * 8 + sub] = cvtpk((float)k0 * sxv[tt & 1][0] + sxv[tt & 1][1], (float)k1 * sxv[tt & 1][0] + sxv[tt & 1][1]);
    };
    ld_e(0); ld_e(1); ld_e(2); ld_x(0); ld_rows(0);
#pragma unroll
    for (int tt = 0; tt < ITEM_TOK; ++tt) {
      if (tt + 1 < ITEM_TOK) { ld_rows(tt + 1); ld_x(tt + 1); }
      if (tt + 3 < ITEM_TOK) ld_e(tt + 3);
      reduce(tt);
    }
  });
}

__device__ __forceinline__ unsigned quant_coef(float c, unsigned E) {
  const float x = fabsf(c) * __uint_as_float((255u - E) << 23);
  const unsigned m = x < 0.25f ? 0u : x < 0.75f ? 1u : x < 1.25f ? 2u : x < 1.75f ? 3u : x < 2.5f ? 4u : x < 3.5f ? 5u : 6u;
  return ((E - 1u) << 8) | m | ((__float_as_uint(c) >> 28) & 8u);
}
__device__ void phase_coef(const Params& p) {
  const unsigned* SELE2 = (const unsigned*)(p.ws + OFF_SELE);
  const f32x2* SELG2 = (const f32x2*)(p.ws + OFF_SELG);
  const unsigned* PD = (const unsigned*)(p.ws + OFF_PD);
  const f32x2* SCL = (const f32x2*)(p.ws + OFF_SCL);
  const f32x4* SCLU = (const f32x4*)(p.ws + OFF_SCLU);
  unsigned* CQ = (unsigned*)(p.ws + OFF_CQ);
  THREAD_IDS
  const size_t istep = (size_t)gridDim.x * NTHREADS, iend = (size_t)NTOK * 64;
  unsigned pdn[4], e2n; f32x2 gtn;
  auto ld = [&](size_t i) {
    const size_t t = i >> 6; const int sp = (int)(i & 63);
#pragma unroll
    for (int q = 0; q < 4; ++q) pdn[q] = PD[(t * 4 + q) * 64 + sp];
    e2n = SELE2[i]; gtn = SELG2[i];
  };
  size_t i = (size_t)blockIdx.x * NTHREADS + tid;
  if (i < iend) ld(i);
  for (; i < iend; i += istep) {
    unsigned pd[4];
#pragma unroll
    for (int q = 0; q < 4; ++q) pd[q] = pdn[q];
    const unsigned e2 = e2n; const f32x2 gt = gtn;
    const float sv0 = SCL[e2 & 0xffffu][1], sv1 = SCL[e2 >> 16][1];
    const f32x4 su0 = SCLU[e2 & 0xffffu], su1 = SCLU[e2 >> 16];
    if (i + istep < iend) ld(i + istep);
    float s0 = 0.f, s1 = 0.f;
#pragma unroll
    for (int q = 0; q < 4; ++q) { s0 += bf_lo(pd[q]) * su0[q]; s1 += bf_hi(pd[q]) * su1[q]; }
    const float c0 = gt[0] * gelu_tanh(s0) * sv0, c1 = gt[1] * gelu_tanh(s1) * sv1;
    const unsigned e0 = (__float_as_uint(c0) >> 23) & 255u, e1 = (__float_as_uint(c1) >> 23) & 255u;
    const unsigned E0 = max(max(e0, (unsigned)dppi<0x128>((int)e0)), 1u), E1 = max(max(e1, (unsigned)dppi<0x128>((int)e1)), 1u);
    CQ[i] = quant_coef(c0, E0) | (quant_coef(c1, E1) << 16);
  }
}

__device__ void phase_vsum(const Params& p) {
  THREAD_IDS const int g = lane >> 3, sub = lane & 7, kg = lane >> 4;
  const unsigned short* SELE = (const unsigned short*)(p.ws + OFF_SELE);
  const unsigned char* CQ = p.ws + OFF_CQ;
  float* SS = (float*)(p.ws + OFF_SS);
  const bool lo8 = (lane & 8) == 0;
  const int jsh = 4 * (lane & 7);
  int one_scale = 0x7f7f7f7f; asm volatile("" : "+v"(one_scale));
  run_queue<4>((unsigned*)(p.ws + OFF_Q) + 8 * 32, [&](int part, int idx) {
    const unsigned char* EV = p.ws + OFF_EV + (size_t)part * SLICE + sub * 16;
    const int t0 = idx * ITEM_TOK;
    u32x4 ev[3][2], rw[2][16], ca[2][2], cb[2][2];
    auto ld_e = [&](int tt) {
#pragma unroll
      for (int i = 0; i < 2; ++i) ev[tt % 3][i] = *(const u32x4*)(SELE + (size_t)(t0 + tt) * 128 + g * 16 + 8 * i);
    };
    auto ld_c = [&](int tt) {
      const unsigned char* c = CQ + (size_t)(t0 + tt) * 256 + kg * 64;
      ca[tt & 1][0] = *(const u32x4*)c; ca[tt & 1][1] = *(const u32x4*)(c + 16); cb[tt & 1][0] = *(const u32x4*)(c + 32); cb[tt & 1][1] = *(const u32x4*)(c + 48);
    };
    auto ld_rows = [&](int tt) {
#pragma unroll
      for (int b = 0; b < 16; ++b) rw[tt & 1][b] = *(const u32x4*)(EV + (size_t)((ev[tt % 3][b >> 3][(b >> 1) & 3] >> (16 * (b & 1))) & 0xffffu) * 128);
    };
    auto reduce = [&](int tt) {
      const int t = t0 + tt;
      f32x4 acc0 = (f32x4){0.f, 0.f, 0.f, 0.f}, acc1 = acc0, acc2 = acc0, acc3 = acc0;
#pragma unroll
      for (int b = 0; b < 16; ++b) {
        const u32x4 w = rw[tt & 1][b];
        const unsigned qa = ca[tt & 1][b >> 3][(b >> 1) & 3] >> (16 * (b & 1)), qb = cb[tt & 1][b >> 3][(b >> 1) & 3] >> (16 * (b & 1));
        const unsigned da = (qa & 15u) << jsh, db = (qb & 15u) << jsh;
        const int sc = (int)(((qa >> 8) & 255u) * 0x01010101u);
        const i32x8v B = {(int)(lo8 ? da : 0u), (int)(lo8 ? 0u : da), (int)(lo8 ? db : 0u), (int)(lo8 ? 0u : db), 0, 0, 0, 0};
        const i32x8v A0 = {(int)(lo8 ? w[0] : 0u), (int)(lo8 ? w[1] : 0u), (int)(lo8 ? 0u : w[0]), (int)(lo8 ? 0u : w[1]), 0, 0, 0, 0};
        const i32x8v A1 = {(int)(lo8 ? w[2] : 0u), (int)(lo8 ? w[3] : 0u), (int)(lo8 ? 0u : w[2]), (int)(lo8 ? 0u : w[3]), 0, 0, 0, 0};
        if (b & 1) {
          acc2 = __builtin_amdgcn_mfma_scale_f32_16x16x128_f8f6f4(A0, B, acc2, 4, 4, 0, one_scale, 0, sc);
          acc3 = __builtin_amdgcn_mfma_scale_f32_16x16x128_f8f6f4(A1, B, acc3, 4, 4, 0, one_scale, 0, sc);
        } else {
          acc0 = __builtin_amdgcn_mfma_scale_f32_16x16x128_f8f6f4(A0, B, acc0, 4, 4, 0, one_scale, 0, sc);
          acc1 = __builtin_amdgcn_mfma_scale_f32_16x16x128_f8f6f4(A1, B, acc1, 4, 4, 0, one_scale, 0, sc);
        }
      }
      acc0 += acc2; acc1 += acc3;
      float r[4];
#pragma unroll
      for (int q = 0; q < 4; ++q) {
        const auto sw = __builtin_amdgcn_permlane32_swap(__float_as_uint(acc0[q]), __float_as_uint(acc1[q]), false, false);
        r[q] = __uint_as_float(sw[0]) + __uint_as_float(sw[1]);
      }
      {
        const int d0 = part * 256 + ((lane >> 4) & 1) * 128 + (lane >> 5) * 16 + (lane & 15);
        const bf16_t* x1 = (const bf16_t*)(p.ws + OFF_X1B) + (size_t)t * DM + d0;
        float v[4], pv[4], ss = 0.f;
#pragma unroll
        for (int q = 0; q < 4; ++q) { v[q] = __uint_as_float((unsigned)x1[32 * q] << 16) + r[q]; ss += v[q] * v[q]; pv[q] = dppf<0xB1>(v[q]); }
        const bool odd = (lane & 1) != 0;
        unsigned* o = (unsigned*)((bf16_t*)(p.ws + OFF_X2B) + (size_t)t * DM + (d0 & ~1) + (odd ? 64 : 0));
        o[0] = cvtpk(odd ? pv[2] : v[0], odd ? v[2] : pv[0]);
        o[16] = cvtpk(odd ? pv[3] : v[1], odd ? v[3] : pv[1]);
        ss = wave_sum(ss);
        if (lane == 0) atomicAdd(SS + t, ss);
      }
    };
    ld_e(0); ld_e(1); ld_e(2); ld_c(0); ld_rows(0);
#pragma unroll
    for (int tt = 0; tt < ITEM_TOK; ++tt) {
      if (tt + 1 < ITEM_TOK) { ld_rows(tt + 1); ld_c(tt + 1); }
      if (tt + 3 < ITEM_TOK) ld_e(tt + 3);
      reduce(tt);
    }
  });
}

__device__ void phase_final(const Params& p) {
  THREAD_IDS
  const float* SS = (const float*)(p.ws + OFF_SS);
  f32x4 gf[4];
#pragma unroll
  for (int i = 0; i < 4; ++i) gf[i] = *(const f32x4*)(p.final_norm_g + i * 256 + lane * 4);
  const int tstep = gridDim.x * 8;
  const bf16_t* X2 = (const bf16_t*)(p.ws + OFF_X2B);
  u32x2 vn[4]; float ssn;
  { const int t0 = blockIdx.x * 8 + wid; ssn = SS[t0];
#pragma unroll
    for (int i = 0; i < 4; ++i) vn[i] = *(const u32x2*)(X2 + (size_t)t0 * DM + i * 256 + lane * 4); }
  for (int t = blockIdx.x * 8 + wid; t < NTOK; t += tstep) {
    const float rs = rsqrtf(ssn * (1.0f / DM) + EPS);
    f32x4 v[4];
#pragma unroll
    for (int i = 0; i < 4; ++i) v[i] = (f32x4){bf_lo(vn[i][0]), bf_hi(vn[i][0]), bf_lo(vn[i][1]), bf_hi(vn[i][1])};
    if (t + tstep < NTOK) { ssn = SS[t + tstep];
#pragma unroll
      for (int i = 0; i < 4; ++i) vn[i] = *(const u32x2*)(X2 + (size_t)(t + tstep) * DM + i * 256 + lane * 4); }
    float* xr = p.out + (size_t)t * DM;
#pragma unroll
    for (int i = 0; i < 4; ++i) *(f32x4*)(xr + i * 256 + lane * 4) = v[i] * gf[i] * rs;
  }
}

#define XB_TMO      128
#define XB_XCNT(j)  (256  + 64 * (j))
#define XB_XSUB(j)  (1280 + 64 * (j))
#define XB_XGEN(j)  (2304 + 64 * (j))
#define XB_TOP      3328
#define XB_TOPGEN   3392
#define XCD_BAR_WORDS 3456
#define XB_SPIN_CAP (1u << 18)
#define LAS __attribute__((address_space(3)))
__device__ __forceinline__ unsigned xb_ld(unsigned* p)              { return __hip_atomic_load(p, __ATOMIC_RELAXED, __HIP_MEMORY_SCOPE_AGENT); }
__device__ __forceinline__ unsigned xb_add(unsigned* p, unsigned v) { return __hip_atomic_fetch_add(p, v, __ATOMIC_RELAXED, __HIP_MEMORY_SCOPE_AGENT); }
__device__ __forceinline__ unsigned xb_xcc_id() { return (unsigned)__builtin_amdgcn_s_getreg((3 << 11) | 20) & 0xFu; }
#define XB_SPIN(cond, bar) do { unsigned _sp = 0; while (cond) { __builtin_amdgcn_s_sleep(1); \
    if ((++_sp & 255u) == 0u) { if (xb_ld(&(bar)[XB_TMO])) break; if (_sp > XB_SPIN_CAP) { atomicAdd(&(bar)[XB_TMO], 1u); break; } } } } while (0)
struct XcdBarrier { unsigned* bar; unsigned x; volatile LAS unsigned* st; };
__device__ __forceinline__ XcdBarrier xcd_barrier_post(unsigned* bar, volatile LAS unsigned* st) {
    XcdBarrier b; b.bar = bar; b.x = xb_xcc_id(); b.st = st;
    if (threadIdx.x == 0) (void)xb_add(&bar[XB_XCNT(b.x)], 1u);
    return b;
}
__device__ __forceinline__ void xcd_barrier_complete(unsigned* bar, unsigned x, unsigned& nloc, unsigned& nx) {
    const unsigned G = gridDim.x * gridDim.y * gridDim.z;
    unsigned sum, cnt, mine, sp = 0u;
    for (;;) {
        sum = 0u; cnt = 0u; mine = 0u;
#pragma unroll
        for (unsigned j = 0; j < 16; ++j) { const unsigned c = xb_ld(&bar[XB_XCNT(j)]); sum += c; cnt += (c > 0u) ? 1u : 0u; mine = (j == x) ? c : mine; }
        if (sum == G) break;
        __builtin_amdgcn_s_sleep(1);
        if ((++sp & 255u) == 0u) { if (xb_ld(&bar[XB_TMO])) break; if (sp > XB_SPIN_CAP) { atomicAdd(&bar[XB_TMO], 1u); break; } }
    }
    nloc = mine > 0u ? mine : 1u; nx = cnt > 0u ? cnt : 1u;
}
__device__ __forceinline__ void xcd_barrier(const XcdBarrier& b) {
    asm volatile("s_waitcnt vmcnt(0)" ::: "memory");
    __syncthreads();
    if (threadIdx.x == 0) {
        unsigned* bar = b.bar;
        __builtin_amdgcn_s_waitcnt(0);
        unsigned nloc = b.st[0], nx = b.st[1];
        if (nloc == 0u) { xcd_barrier_complete(bar, b.x, nloc, nx); b.st[0] = nloc; b.st[1] = nx; }
        const unsigned old = xb_add(&bar[XB_XSUB(b.x)], 1u);
        const unsigned gen = old / nloc;
        if (old + 1u == (gen + 1u) * nloc) {
            __builtin_amdgcn_fence(__ATOMIC_RELEASE, "agent");
            asm volatile("s_waitcnt vmcnt(0)" ::: "memory");
            const unsigned og = xb_add(&bar[XB_TOP], 1u);
            const unsigned tg = og / nx;
            if (og + 1u == (tg + 1u) * nx) xb_add(&bar[XB_TOPGEN], 1u);
            else XB_SPIN(xb_ld(&bar[XB_TOPGEN]) == tg, bar);
            __builtin_amdgcn_fence(__ATOMIC_ACQUIRE, "agent");
            xb_add(&bar[XB_XGEN(b.x)], 1u);
            asm volatile("s_waitcnt vmcnt(0)" ::: "memory");
        } else {
            XB_SPIN(xb_ld(&bar[XB_XGEN(b.x)]) == gen, bar);
            __builtin_amdgcn_fence(__ATOMIC_ACQUIRE, "agent");
            asm volatile("s_waitcnt vmcnt(0)" ::: "memory");
        }
    }
    __syncthreads();
}

#ifndef PHASES
#define PHASES 0x7f
#endif
#ifndef DUP
#define DUP 0
#endif
__global__ void __launch_bounds__(NTHREADS) fwd_megakernel(Params p) {
  cg::grid_group grid = cg::this_grid();
  extern __shared__ __attribute__((aligned(16))) unsigned char smem[];
  unsigned char* ws = p.ws;
  unsigned* bar = (unsigned*)(ws + OFF_BAR);
  volatile LAS unsigned* st = (volatile LAS unsigned*)(LAS unsigned char*)(smem + 143360);
  if (blockIdx.x == 0) for (int i = threadIdx.x; i < XCD_BAR_WORDS; i += NTHREADS) bar[i] = 0u;
  if (threadIdx.x == 0) { st[0] = 0u; st[1] = 0u; }
#if PHASES & 1
  for (int rep = 0; rep < 1 + ((DUP >> 0) & 1); ++rep) { phase_prep(p, smem); __syncthreads(); }
#endif
  grid.sync();
  const XcdBarrier xb = xcd_barrier_post(bar, st);
  quant_weight_rows<2>((const bf16_t*)(ws + OFF_WIN), ws + OFF_WIN8, (float*)(ws + OFF_WSC) + 2048, 2560);
  quant_weight_rows<2>((const bf16_t*)(ws + OFF_WQ), ws + OFF_WQ8, (float*)(ws + OFF_WSC), 2048);
  quant_weight_rows<2>((const bf16_t*)(ws + OFF_WOUT), ws + OFF_WOUT8, (float*)(ws + OFF_WSC) + 4608, 1024);
  xcd_barrier(xb);
#if PHASES & 2
  for (int rep = 0; rep < 1 + ((DUP >> 1) & 1); ++rep)
  { EpiIn e{(bf16_t*)(ws + OFF_P), (const f32x2*)(ws + OFF_RT), (const float*)(ws + OFF_SAH), (const float*)(ws + OFF_WSC) + 2048}; StaticOrder so; so.init(NTOK, DIN, gridDim.x, blockIdx.x);
    gemm_phase<EpiIn, StaticOrder, true>(smem, (const bf16_t*)(ws + OFF_H8), (const bf16_t*)(ws + OFF_WIN8), DM / 2, so, e, (const float*)(ws + OFF_SAH), (const float*)(ws + OFF_WSC) + 2048); }
#endif
  xcd_barrier(xb);
#if PHASES & 4
  for (int rep = 0; rep < 1 + ((DUP >> 8) & 1); ++rep) attn_phase(p, smem);
  for (int rep = 0; rep < 1 + ((DUP >> 9) & 1); ++rep)
    for (int item = blockIdx.x; item < 512; item += gridDim.x) spatial_item(p, item, smem);
  xcd_barrier(xb);
  for (int rep = 0; rep < 1 + ((DUP >> 10) & 1); ++rep) attn_merge_phase(p);
#endif
  xcd_barrier(xb);
#if PHASES & 8
  for (int rep = 0; rep < 1 + ((DUP >> 3) & 1); ++rep)
  { EpiOut e{p.x, (bf16_t*)(ws + OFF_X1B), (const float*)(ws + OFF_SAM), (const float*)(ws + OFF_WSC) + 4608}; StaticOrder so; so.init(NTOK, DM, gridDim.x, blockIdx.x);
    gemm_phase<EpiOut, StaticOrder, true>(smem, (const bf16_t*)(ws + OFF_MIX8), (const bf16_t*)(ws + OFF_WOUT8), DM / 2, so, e); }
#endif
  xcd_barrier(xb);
#if PHASES & 16
  for (int rep = 0; rep < 1 + ((DUP >> 4) & 1); ++rep) phase_xn(p);
#endif
  xcd_barrier(xb);
#if PHASES & 32
  for (int rep = 0; rep < 1 + ((DUP >> 5) & 1); ++rep)
  { EpiSel e{(unsigned short*)(ws + OFF_SELE), (float*)(ws + OFF_SELG), (const float*)(ws + OFF_RS), &p, 0}; StaticOrder so; so.init(NTOK, 2048, gridDim.x, blockIdx.x);
    OneUnit one;
    Unit nu; bool pre = false;
    for (int i = 0; so.next(i, one.u); ++i) { e.useq = i * (int)gridDim.x + (int)blockIdx.x; const bool hn = so.next(i + 1, nu);
      gemm_phase<EpiSel, OneUnit, true>(smem, (const bf16_t*)(ws + OFF_X8), (const bf16_t*)(ws + OFF_WQ8), DM / 2, one, e, (const float*)(ws + OFF_SA8), (const float*)(ws + OFF_WSC), hn ? nu : Unit{-1, 0}, pre); pre = hn; } }
#endif
  xcd_barrier(xb);
#if PHASES & 64
  phase_udot(p, 0);
#if DUP & 4096
  phase_udot(p, 512);
#endif
  xcd_barrier(xb);
  phase_coef(p);
  xcd_barrier(xb);
  phase_vsum(p);
  xcd_barrier(xb);
  phase_final(p);
#endif
}

extern "C" void kernel_launch(void* const* d_in, const int* in_sizes, int n_in, void* d_out, int out_size, void* d_ws, size_t ws_size, hipStream_t stream) {
  static int grid_blocks = 0;
  if (!grid_blocks) {
    if (hipFuncSetAttribute((const void*)fwd_megakernel, hipFuncAttributeMaxDynamicSharedMemorySize, LDS_BYTES) != hipSuccess) { fprintf(stderr, "hipFuncSetAttribute failed\n"); }
    int dev = 0, cus = 0, per_cu = 0;
    (void)hipGetDevice(&dev);
    (void)hipDeviceGetAttribute(&cus, hipDeviceAttributeMultiprocessorCount, dev);
    (void)hipOccupancyMaxActiveBlocksPerMultiprocessor(&per_cu, (const void*)fwd_megakernel, NTHREADS, LDS_BYTES);
    if (per_cu < 1) { fprintf(stderr, "occupancy query says 0 blocks/CU\n"); per_cu = 1; }
    grid_blocks = cus;
  }
  if (ws_size < WS_NEED) { fprintf(stderr, "workspace too small: %zu < %zu\n", ws_size, WS_NEED); return; }
  Params p{};
  p.x = (const float*)d_in[0]; p.norm1_g = (const float*)d_in[1]; p.w_in = (const float*)d_in[2]; p.ln_v_g = (const float*)d_in[3]; p.ln_v_b = (const float*)d_in[4];
  p.w_spatial = (const float*)d_in[5]; p.b_spatial = (const float*)d_in[6]; p.out_norm_a_g = (const float*)d_in[7]; p.out_norm_b_g = (const float*)d_in[8];
  p.w_out = (const float*)d_in[9]; p.norm2_g = (const float*)d_in[10]; p.w_query = (const float*)d_in[11]; p.sub_keys = (const float*)d_in[12];
  p.expert_u = (const float*)d_in[13]; p.expert_v = (const float*)d_in[14]; p.final_norm_g = (const float*)d_in[15];
  p.out = (float*)d_out; p.ws = (unsigned char*)d_ws;
  void* args[] = {&p};
  hipError_t e = hipLaunchCooperativeKernel((void*)fwd_megakernel, dim3(grid_blocks), dim3(NTHREADS), args, LDS_BYTES, stream);
  if (e != hipSuccess) fprintf(stderr, "cooperative launch failed: %s (grid %d)\n", hipGetErrorString(e), grid_blocks);
}
```

```cpp
#include <hip/hip_runtime.h>
#include <hip/hip_cooperative_groups.h>
#include <cstdio>
#include <cstdint>
namespace cg = cooperative_groups;

typedef unsigned short bf16_t;
typedef short bf16x8 __attribute__((ext_vector_type(8)));
typedef short s16x4 __attribute__((ext_vector_type(4)));
typedef float f32x4 __attribute__((ext_vector_type(4)));
typedef int i32x8v __attribute__((ext_vector_type(8)));
typedef float f32x2 __attribute__((ext_vector_type(2)));
typedef unsigned u32x4 __attribute__((ext_vector_type(4)));
typedef unsigned u32x2 __attribute__((ext_vector_type(2)));
typedef int i32x4v __attribute__((ext_vector_type(4)));
typedef __bf16 bf16x2v __attribute__((ext_vector_type(2)));

constexpr int NTOK = 65536, SEQ = 2048, DM = 1024, DIN = 2560, NEXP = 16384;
constexpr float EPS = 1e-6f;
constexpr int NTHREADS = 512;
constexpr int LDS_BYTES = 143360 + 16;

constexpr size_t MB = 1024 * 1024;
constexpr size_t OFF_RT = 0;
constexpr size_t OFF_WIN = 1 * MB;
constexpr size_t OFF_WOUT = 6 * MB;
constexpr size_t OFF_WQ = 8 * MB;
constexpr size_t OFF_SK = 12 * MB;
constexpr size_t OFF_WSP = 12 * MB + 65536;
constexpr size_t OFF_EU = 13 * MB;
constexpr size_t OFF_EV = 45 * MB;
constexpr size_t OFF_SCL = 76 * MB;
constexpr size_t OFF_SCLU = 76 * MB + 262144;
constexpr size_t OFF_H = 77 * MB;
constexpr size_t OFF_MIX = 205 * MB;
constexpr size_t OFF_XN = 333 * MB;
constexpr size_t OFF_P = 461 * MB;
constexpr size_t OFF_SELE = 781 * MB;
constexpr size_t OFF_SELG = 813 * MB;
constexpr size_t OFF_XQ = OFF_H;
constexpr size_t OFF_SX = OFF_H + 64 * MB;
constexpr size_t OFF_PD = OFF_P;
constexpr size_t OFF_X2B = OFF_MIX;
constexpr size_t OFF_CQ = OFF_P + 64 * MB;
constexpr size_t OFF_SS = 845 * MB;
constexpr size_t OFF_Q = 845 * MB + 262144;
constexpr size_t OFF_RS = 845 * MB + 393216;
constexpr size_t OFF_BAR = 845 * MB + 786432;
constexpr size_t OFF_X1B = 846 * MB;
constexpr size_t OFF_X8 = OFF_XN;
constexpr size_t OFF_SA8 = OFF_XN + 64 * MB;
constexpr size_t OFF_WQ8 = 975 * MB;
constexpr size_t OFF_WIN8 = 977 * MB;
constexpr size_t OFF_WOUT8 = 980 * MB;
constexpr size_t OFF_WSC = 983 * MB;
constexpr size_t OFF_MIX8 = OFF_MIX;
constexpr size_t OFF_SAM = OFF_MIX + 64 * MB;
constexpr size_t OFF_H8 = OFF_H;
constexpr size_t OFF_SAH = OFF_H + 64 * MB;
constexpr size_t WS_NEED = 984 * MB;
constexpr size_t SLICE = (size_t)NEXP * 128;

struct Params {
  const float* x; const float* norm1_g; const float* w_in; const float* ln_v_g; const float* ln_v_b;
  const float* w_spatial; const float* b_spatial; const float* out_norm_a_g; const float* out_norm_b_g;
  const float* w_out; const float* norm2_g; const float* w_query; const float* sub_keys;
  const float* expert_u; const float* expert_v; const float* final_norm_g;
  float* out; unsigned char* ws;
};

__device__ __forceinline__ unsigned cvtpk(float lo, float hi) { unsigned r; asm volatile("v_cvt_pk_bf16_f32 %0, %1, %2" : "=v"(r) : "v"(lo), "v"(hi)); return r; }
__device__ __forceinline__ float bf_lo(unsigned w) { return __uint_as_float(w << 16); }
__device__ __forceinline__ float bf_hi(unsigned w) { return __uint_as_float(w & 0xffff0000u); }
__device__ __forceinline__ float dot2(unsigned a, unsigned b, float acc) { return __builtin_amdgcn_fdot2_f32_bf16(__builtin_bit_cast(bf16x2v, a), __builtin_bit_cast(bf16x2v, b), acc, false); }
__device__ __forceinline__ float gelu_tanh(float x) {
  const float u = x * (1.5957691216057308f + 0.07135481627260026f * x * x);
  return x * __builtin_amdgcn_rcpf(1.0f + __expf(-u));
}
__device__ __forceinline__ f32x4 gelu_tanh4(f32x4 x) {
  const f32x4 u = x * (1.5957691216057308f + 0.07135481627260026f * (x * x));
  f32x4 d;
#pragma unroll
  for (int r = 0; r < 4; ++r) d[r] = __expf(-u[r]);
  d = d + 1.0f;
#pragma unroll
  for (int r = 0; r < 4; ++r) d[r] = __builtin_amdgcn_rcpf(d[r]);
  return x * d;
}
template <int CTRL> __device__ __forceinline__ float dppf(float x) { return __builtin_bit_cast(float, __builtin_amdgcn_mov_dpp(__builtin_bit_cast(int, x), CTRL, 0xf, 0xf, true)); }
__device__ __forceinline__ float sum8(float s) { s += dppf<0xB1>(s); s += dppf<0x4E>(s); s += dppf<0x141>(s); return s; }
__device__ __forceinline__ float max8(float s) { s = fmaxf(s, dppf<0xB1>(s)); s = fmaxf(s, dppf<0x4E>(s)); s = fmaxf(s, dppf<0x141>(s)); return s; }
__device__ __forceinline__ float sum_x16(float v) { const auto w = __builtin_amdgcn_permlane16_swap(__float_as_uint(v), __float_as_uint(v), false, false); return __uint_as_float(w[0]) + __uint_as_float(w[1]); }
__device__ __forceinline__ float sum_x32(float v) { const auto w = __builtin_amdgcn_permlane32_swap(__float_as_uint(v), __float_as_uint(v), false, false); return __uint_as_float(w[0]) + __uint_as_float(w[1]); }
__device__ __forceinline__ float max_x16(float v) { const auto w = __builtin_amdgcn_permlane16_swap(__float_as_uint(v), __float_as_uint(v), false, false); return fmaxf(__uint_as_float(w[0]), __uint_as_float(w[1])); }
__device__ __forceinline__ float max_x32(float v) { const auto w = __builtin_amdgcn_permlane32_swap(__float_as_uint(v), __float_as_uint(v), false, false); return fmaxf(__uint_as_float(w[0]), __uint_as_float(w[1])); }
__device__ __forceinline__ float sum16(float v) { v = sum8(v); return v + dppf<0x128>(v); }
__device__ __forceinline__ float max16(float v) { v = max8(v); return fmaxf(v, dppf<0x128>(v)); }
__device__ __forceinline__ float wave_sum(float v) { return sum_x32(sum_x16(sum16(v))); }
__device__ __forceinline__ float wave_max(float v) { return max_x32(max_x16(max16(v))); }
__device__ __forceinline__ int lane_id_opaque() { int l; asm volatile("v_mbcnt_lo_u32_b32 %0, -1, 0\n\tv_mbcnt_hi_u32_b32 %0, -1, %0" : "=v"(l)); return l; }
#define THREAD_IDS const int lane = lane_id_opaque(); const int wid = __builtin_amdgcn_readfirstlane((int)(threadIdx.x >> 6)); const int tid = wid * 64 + lane; (void)tid; (void)wid;
#define WAIT_V(n) asm volatile("s_waitcnt vmcnt(%0)" ::"n"(n) : "memory")
#define WAIT_L(n) asm volatile("s_waitcnt lgkmcnt(%0)" ::"n"(n) : "memory")

__device__ __forceinline__ void convert_expert_row(const Params& p, int r, int lane) {
  unsigned char* ws = p.ws;
  const int tab = r >= NEXP, e = r - tab * NEXP;
  const float* src = (tab ? p.expert_v : p.expert_u) + (size_t)e * DM + lane * 16;
  f32x4 v[4]; float am = 0.f;
#pragma unroll
  for (int i = 0; i < 4; ++i) { v[i] = __builtin_nontemporal_load((const f32x4*)(src + 4 * i)); am = fmaxf(am, fmaxf(fmaxf(fabsf(v[i][0]), fabsf(v[i][1])), fmaxf(fabsf(v[i][2]), fabsf(v[i][3])))); }
  if (tab) {
    am = wave_max(am);
    const float qs = am > 0.f ? 6.0f / am : 1.0f, dq = am > 0.f ? am * (1.0f / 6.0f) : 1.0f;
    u32x2 w = (u32x2){0u, 0u};
#pragma unroll
    for (int i = 0; i < 4; ++i)
#pragma unroll
      for (int j = 0; j < 4; ++j) {
        const float x = v[i][j] * qs, a = fabsf(x);
        const unsigned m = a < 0.25f ? 0u : a < 0.75f ? 1u : a < 1.25f ? 2u : a < 1.75f ? 3u : a < 2.5f ? 4u : a < 3.5f ? 5u : a < 5.0f ? 6u : 7u;
        const unsigned c = m | (x < 0.f ? 8u : 0u);
        w[i >> 1] |= c << (4 * (4 * (i & 1) + j));
      }
    *(u32x2*)(ws + OFF_EV + (size_t)(lane >> 4) * SLICE + (size_t)e * 128 + (lane & 15) * 8) = w;
    if (lane == 0) ((float*)(ws + OFF_SCL))[2 * e + 1] = dq;
  } else {
    am = 0.f;
    f32x4 vg[4];
#pragma unroll
    for (int i = 0; i < 4; ++i) { vg[i] = v[i] * *(const f32x4*)(p.norm2_g + lane * 16 + 4 * i); am = fmaxf(am, fmaxf(fmaxf(fabsf(vg[i][0]), fabsf(vg[i][1])), fmaxf(fabsf(vg[i][2]), fabsf(vg[i][3])))); }
    am = max16(am);
    const float qs = am > 0.f ? 8.0f / am : 0.f, dq = am * 0.125f;
    u32x2 w = (u32x2){0u, 0u};
#pragma unroll
    for (int i = 0; i < 4; ++i)
#pragma unroll
      for (int j = 0; j < 4; ++j) {
        const int n = (int)fminf(fmaxf(floorf(vg[i][j] * qs), -8.0f), 7.0f);
        w[i >> 1] |= ((unsigned)n & 15u) << (4 * ((i & 1) ? 2 * j + 1 : 2 * j));
      }
    *(u32x2*)(ws + OFF_EU + (size_t)(lane >> 4) * SLICE + (size_t)e * 128 + (lane & 15) * 8) = w;
    if ((lane & 15) == 0) ((float*)(ws + OFF_SCLU))[4 * e + (lane >> 4)] = dq;
  }
}

__device__ void phase_prep(const Params& p, unsigned char* smem) {
  THREAD_IDS
  unsigned char* ws = p.ws;
  {
    float* T = (float*)smem;
    constexpr int T_IN = 16 * 40, T_OUT = 16 * 16, T_Q = 16 * 32;
    for (int tile = blockIdx.x; tile < T_IN + T_OUT; tile += gridDim.x) {
      const float* src; bf16_t* dst; int N, tt;
      if (tile < T_IN) { src = p.w_in; dst = (bf16_t*)(ws + OFF_WIN); N = 2560; tt = tile; }
      else if (tile < T_IN + T_OUT) { src = p.w_out; dst = (bf16_t*)(ws + OFF_WOUT); N = 1024; tt = tile - T_IN; }
      else { src = p.w_query; dst = (bf16_t*)(ws + OFF_WQ); N = 2048; tt = tile - T_IN - T_OUT; }
      const int nt = N / 64, k0 = (tt / nt) * 64, n0 = (tt % nt) * 64;
#pragma unroll
      for (int i = 0; i < 2; ++i) {
        const int r = (tid >> 4) + 32 * i, c4 = (tid & 15) * 4;
        const f32x4 v = *(const f32x4*)(src + (size_t)(k0 + r) * N + n0 + c4);
        T[r * 65 + c4 + 0] = v[0]; T[r * 65 + c4 + 1] = v[1]; T[r * 65 + c4 + 2] = v[2]; T[r * 65 + c4 + 3] = v[3];
      }
      __syncthreads();
      {
        const int n = tid >> 3, k8 = (tid & 7) * 8;
        u32x4 w;
        float gk[8];
#pragma unroll
        for (int j = 0; j < 8; ++j) gk[j] = (tile >= T_IN + T_OUT) ? p.norm2_g[k0 + k8 + j] : 1.0f;
        w[0] = cvtpk(T[(k8 + 0) * 65 + n] * gk[0], T[(k8 + 1) * 65 + n] * gk[1]); w[1] = cvtpk(T[(k8 + 2) * 65 + n] * gk[2], T[(k8 + 3) * 65 + n] * gk[3]);
        w[2] = cvtpk(T[(k8 + 4) * 65 + n] * gk[4], T[(k8 + 5) * 65 + n] * gk[5]); w[3] = cvtpk(T[(k8 + 6) * 65 + n] * gk[6], T[(k8 + 7) * 65 + n] * gk[7]);
        int nr = n0 + n;
        if (tile < T_IN) {
          if (nr >= 1024 && nr < 2048) nr = (nr & ~48) | ((nr & 16) << 1) | ((nr & 32) >> 1);
          else { const int a = nr & 31; nr = (nr & ~31) | (((a >> 2) & 1) << 4) | ((a >> 3) << 2) | (a & 3); }
        }
        *(u32x4*)(dst + (size_t)nr * 1024 + k0 + k8) = w;
      }
      __syncthreads();
    }
  }
  {
    const size_t gt = (size_t)blockIdx.x * NTHREADS + tid, gn = (size_t)gridDim.x * NTHREADS;
    const float* srcs[1] = {p.w_spatial};
    const size_t offs[1] = {OFF_WSP};
    const size_t cnts[1] = {8 * 128 * 128 / 8};
#pragma unroll
    for (int a = 0; a < 1; ++a) {
      const float* s = srcs[a]; bf16_t* d = (bf16_t*)(ws + offs[a]);
      for (size_t i = gt; i < cnts[a]; i += gn) {
        const f32x4 v0 = *(const f32x4*)(s + i * 8), v1 = *(const f32x4*)(s + i * 8 + 4);
        u32x4 w; w[0] = cvtpk(v0[0], v0[1]); w[1] = cvtpk(v0[2], v0[3]); w[2] = cvtpk(v1[0], v1[1]); w[3] = cvtpk(v1[2], v1[3]);
        *(u32x4*)(d + i * 8) = w;
      }
    }
    f32x2* RT = (f32x2*)(ws + OFF_RT);
    for (size_t i = gt; i < (size_t)SEQ * 32; i += gn) {
      const int pos = (int)(i >> 5), j = (int)(i & 31);
      const double inv = pow(10000.0, -(double)j / 32.0), ang = (double)pos * inv;
      f32x2 cs; cs[0] = (float)cos(ang); cs[1] = (float)sin(ang);
      RT[i] = cs;
    }
  }
  {
    bf16_t* WQ = (bf16_t*)(ws + OFF_WQ);
    const int fr = lane & 15, fq = lane >> 4;
    for (int tile = blockIdx.x * 8 + wid; tile < 16 * 8 * 64; tile += gridDim.x * 8) {
      const int hp = tile >> 9, kt = (tile >> 6) & 7, dt = tile & 63, pp = hp & 1;
      f32x4 acc = (f32x4){0.f, 0.f, 0.f, 0.f};
#pragma unroll
      for (int ks = 0; ks < 4; ++ks) {
        const float* ap = p.w_query + (size_t)(dt * 16 + fr) * 2048 + hp * 128 + ks * 32 + fq * 8;
        const float* bp = p.sub_keys + ((size_t)pp * 128 + kt * 16 + fr) * 128 + ks * 32 + fq * 8;
        const f32x4 a0 = *(const f32x4*)ap, a1 = *(const f32x4*)(ap + 4), b0 = *(const f32x4*)bp, b1 = *(const f32x4*)(bp + 4);
        u32x4 aw, bw;
        aw[0] = cvtpk(a0[0], a0[1]); aw[1] = cvtpk(a0[2], a0[3]); aw[2] = cvtpk(a1[0], a1[1]); aw[3] = cvtpk(a1[2], a1[3]);
        bw[0] = cvtpk(b0[0], b0[1]); bw[1] = cvtpk(b0[2], b0[3]); bw[2] = cvtpk(b1[0], b1[1]); bw[3] = cvtpk(b1[2], b1[3]);
        acc = __builtin_amdgcn_mfma_f32_16x16x32_bf16(__builtin_bit_cast(bf16x8, aw), __builtin_bit_cast(bf16x8, bw), acc, 0, 0, 0);
      }
      const f32x4 g2 = *(const f32x4*)(p.norm2_g + dt * 16 + 4 * fq);
      u32x2 w; w[0] = cvtpk(acc[0] * g2[0], acc[1] * g2[1]); w[1] = cvtpk(acc[2] * g2[2], acc[3] * g2[3]);
      *(u32x2*)(WQ + (size_t)(hp * 128 + kt * 16 + fr) * 1024 + dt * 16 + 4 * fq) = w;
    }
  }
  {
    float* SS = (float*)(ws + OFF_SS);
    for (int i = blockIdx.x * NTHREADS + tid; i < NTOK; i += gridDim.x * NTHREADS) SS[i] = 0.f;
    if (blockIdx.x == 0 && tid < 16 * 32) { ((unsigned*)(ws + OFF_Q))[tid] = 0u; ((unsigned*)(ws + OFF_Q))[512 + tid] = 0u; }
  }
  {
    f32x4 g[4];
#pragma unroll
    for (int i = 0; i < 4; ++i) g[i] = *(const f32x4*)(p.norm1_g + (i >> 1) * 512 + lane * 8 + (i & 1) * 4);
    const int rstep = gridDim.x * 8;
    f32x4 vn[4];
    { const int r0 = blockIdx.x * 8 + wid;
#pragma unroll
      for (int i = 0; i < 4; ++i) vn[i] = __builtin_nontemporal_load((const f32x4*)(p.x + (size_t)r0 * DM + (i >> 1) * 512 + lane * 8 + (i & 1) * 4)); }
    for (int row = blockIdx.x * 8 + wid; row < NTOK; row += rstep) {
      f32x4 v[4]; float ss = 0.f;
#pragma unroll
      for (int i = 0; i < 4; ++i) { v[i] = vn[i]; ss += v[i][0] * v[i][0] + v[i][1] * v[i][1] + v[i][2] * v[i][2] + v[i][3] * v[i][3]; }
      if (row + rstep < NTOK) {
#pragma unroll
        for (int i = 0; i < 4; ++i) vn[i] = __builtin_nontemporal_load((const f32x4*)(p.x + (size_t)(row + rstep) * DM + (i >> 1) * 512 + lane * 8 + (i & 1) * 4));
      }
      ss = wave_sum(ss);
      const float rs = rsqrtf(ss * (1.0f / DM) + EPS);
      float am = 0.f;
#pragma unroll
      for (int i = 0; i < 4; ++i) { v[i] = v[i] * g[i] * rs; am = fmaxf(am, fmaxf(fmaxf(fabsf(v[i][0]), fabsf(v[i][1])), fmaxf(fabsf(v[i][2]), fabsf(v[i][3])))); }
      am = wave_max(am);
      const float qs = am > 0.f ? 127.0f / am : 0.f;
#pragma unroll
      for (int hf = 0; hf < 2; ++hf) {
        u32x2 q;
#pragma unroll
        for (int e = 0; e < 2; ++e) {
          const f32x4 a = v[2 * hf + e] * qs;
          q[e] = ((unsigned)__float2int_rn(a[0]) & 0xffu) | (((unsigned)__float2int_rn(a[1]) & 0xffu) << 8) | (((unsigned)__float2int_rn(a[2]) & 0xffu) << 16) | ((unsigned)__float2int_rn(a[3]) << 24);
        }
        *(u32x2*)(ws + OFF_H8 + (size_t)row * DM + hf * 512 + lane * 8) = q;
      }
      if (lane == 0) ((float*)(ws + OFF_SAH))[row] = am * (1.0f / 127.0f);
    }
  }
}

constexpr int HTB = 128 * 64 * 2;
__device__ __forceinline__ int lds_byte(int r, int c) { const int st = (r >> 4) * 2 + (c >> 5), ob = (r & 15) * 64 + (c & 31) * 2; return st * 1024 + (ob ^ (((ob >> 9) & 1) << 5)); }
__device__ __forceinline__ void stage_rc(int b, int& R, int& C) { const int st = b >> 10, sb = b & 1023, swz = sb ^ (((sb >> 9) & 1) << 5); R = (st >> 1) * 16 + swz / 64; C = (st & 1) * 32 + (swz % 64) / 2; }
struct Unit { int pm, pn; };
struct StaticOrder {
  int nM, nN, nwg, G, c;
  __device__ void init(int M, int N, int G_, int c_) { nM = M / 256; nN = N / 256; nwg = nM * nN; G = G_; c = c_; }
  __device__ bool next(int i, Unit& u) const {
    const long L = (long)i * G + c; if (L >= nwg) return false;
    int wgid = (int)L; { const int q = nwg / 8, r = nwg % 8, xcd = wgid % 8, off = wgid / 8; wgid = (xcd < r ? xcd * (q + 1) : r * (q + 1) + (xcd - r) * q) + off; }
    const int nig = 8 * nN, gid = wgid / nig, fm = gid * 8, gsz = (nM - fm) < 8 ? (nM - fm) : 8;
    u.pm = fm + ((wgid % nig) % gsz); u.pn = (wgid % nig) / gsz; return true;
  }
};
struct OneUnit { Unit u; __device__ bool next(int i, Unit& o) const { if (i) return false; o = u; return true; } };

template <class Epi, class Sched, bool I8 = false>
__device__ __forceinline__ void gemm_phase(unsigned char* smem, const bf16_t* Ag, const bf16_t* Btg, const int K, const Sched& S, const Epi& E, const float* SA = nullptr, const float* SB = nullptr) {
  THREAD_IDS const int wr = wid >> 2, wc = wid & 3, fr = lane & 15, fq = lane >> 4;
  __attribute__((address_space(3))) unsigned char* lds = (__attribute__((address_space(3))) unsigned char*)smem;
  const int nt = K / 64;
  unsigned voff[2];
#pragma unroll
  for (int i = 0; i < 2; ++i) { int R, C; stage_rc(tid * 16 + i * 8192, R, C); voff[i] = (unsigned)(R * K + C) * 2u; }
  const size_t kstep = 128, hstep = (size_t)128 * K * 2, tstep = 2 * hstep;
  const unsigned ldsw = (unsigned)wid * 1024u;
  const int aoff = lds_byte(wr * 64 + fr, fq * 8), boff = lds_byte(wc * 32 + fr, fq * 8);
#define PG8_SA(b, h) (((b) * 2 + (h)) * HTB)
#define PG8_SB(b, h) ((4 + (b) * 2 + (h)) * HTB)
#define PG8_STAGE(bufoff, gbase) do { _Pragma("unroll") for (int _i = 0; _i < 2; ++_i) \
    __builtin_amdgcn_global_load_lds((const unsigned*)((const char*)(gbase) + voff[_i]), (__attribute__((address_space(3))) unsigned*)(lds + (bufoff) + ldsw + _i * 8192), 16, 0, 0); } while (0)
#define PG8_LDA(dst, b, h) do { _Pragma("unroll") for (int m = 0; m < 4; ++m) _Pragma("unroll") for (int k = 0; k < 2; ++k) dst[m][k] = *(const __attribute__((address_space(3))) bf16x8*)(lds + PG8_SA(b, h) + aoff + m * 2048 + k * 1024); } while (0)
#define PG8_LDB(dst, b, h) do { _Pragma("unroll") for (int n = 0; n < 2; ++n) _Pragma("unroll") for (int k = 0; k < 2; ++k) dst[n][k] = *(const __attribute__((address_space(3))) bf16x8*)(lds + PG8_SB(b, h) + boff + n * 2048 + k * 1024); } while (0)
#define PG8_MMA(ai, bj, At, Bt) do { __builtin_amdgcn_s_setprio(1); _Pragma("unroll") for (int m = 0; m < 4; ++m) _Pragma("unroll") for (int n = 0; n < 2; ++n) _Pragma("unroll") for (int k = 0; k < 2; ++k) \
    { if constexpr (I8) acc[ai][bj][m][n] = __builtin_bit_cast(f32x4, __builtin_amdgcn_mfma_i32_16x16x64_i8(__builtin_bit_cast(i32x4v, Bt[n][k]), __builtin_bit_cast(i32x4v, At[m][k]), __builtin_bit_cast(i32x4v, acc[ai][bj][m][n]), 0, 0, 0)); \
      else acc[ai][bj][m][n] = __builtin_amdgcn_mfma_f32_16x16x32_bf16(Bt[n][k], At[m][k], acc[ai][bj][m][n], 0, 0, 0); } __builtin_amdgcn_s_setprio(0); } while (0)
#define PG8_WAIT_V(n) asm volatile("s_waitcnt vmcnt(" #n ")" ::: "memory")
#define PG8_WAIT_L(n) asm volatile("s_waitcnt lgkmcnt(" #n ")" ::: "memory")
#define PG8_BAR __builtin_amdgcn_s_barrier()
#define PG8_SCHED __builtin_amdgcn_sched_barrier(0)
  Unit cur, nxt; int ui = 0;
  if (!S.next(0, cur)) return;
  f32x4 acc[2][2][4][2];
#pragma unroll
  for (int a = 0; a < 2; ++a)
#pragma unroll
    for (int b = 0; b < 2; ++b)
#pragma unroll
      for (int m = 0; m < 4; ++m)
#pragma unroll
        for (int n = 0; n < 2; ++n) acc[a][b][m][n] = (f32x4){0.f, 0.f, 0.f, 0.f};
  bf16x8 At[4][2], B0[2][2], B1[2][2];
  const char* cA = (const char*)Ag + (size_t)cur.pm * tstep; const char* cB = (const char*)Btg + (size_t)cur.pn * tstep;
  auto rescale = [&]() {
    float sa[2][4]; f32x4 sb[2][2];
#pragma unroll
    for (int a = 0; a < 2; ++a)
#pragma unroll
      for (int m = 0; m < 4; ++m) sa[a][m] = SA[cur.pm * 256 + a * 128 + wr * 64 + m * 16 + fr];
#pragma unroll
    for (int b = 0; b < 2; ++b)
#pragma unroll
      for (int n = 0; n < 2; ++n) sb[b][n] = *(const f32x4*)(SB + cur.pn * 256 + b * 128 + wc * 32 + n * 16 + 4 * fq);
#pragma unroll
    for (int a = 0; a < 2; ++a)
#pragma unroll
      for (int b = 0; b < 2; ++b)
#pragma unroll
        for (int m = 0; m < 4; ++m)
#pragma unroll
          for (int n = 0; n < 2; ++n) {
            const i32x4v iv = __builtin_bit_cast(i32x4v, acc[a][b][m][n]);
            acc[a][b][m][n] = (f32x4){(float)iv[0], (float)iv[1], (float)iv[2], (float)iv[3]} * sb[b][n] * sa[a][m];
          }
  };
  PG8_STAGE(PG8_SB(0, 0), cB); PG8_STAGE(PG8_SA(0, 0), cA); PG8_STAGE(PG8_SB(0, 1), cB + hstep); PG8_STAGE(PG8_SA(0, 1), cA + hstep);
  if (wr == 1) PG8_BAR;
  PG8_WAIT_V(4); PG8_BAR;
  PG8_STAGE(PG8_SB(1, 0), cB + kstep); PG8_STAGE(PG8_SA(1, 0), cA + kstep); PG8_STAGE(PG8_SB(1, 1), cB + hstep + kstep);
  PG8_WAIT_V(6); PG8_BAR;
  for (;;) {
    const bool has_next = S.next(ui + 1, nxt);
    const char* nA = has_next ? (const char*)Ag + (size_t)nxt.pm * tstep : cA; const char* nB = has_next ? (const char*)Btg + (size_t)nxt.pn * tstep : cB;
    for (int t = 0; t < nt; t += 2) {
      const bool last = (t == nt - 2);
      const char* a1 = cA + (size_t)(t + 1) * kstep;
      const char* a2 = last ? nA : cA + (size_t)(t + 2) * kstep; const char* b2 = last ? nB : cB + (size_t)(t + 2) * kstep;
      const char* a3 = a2 + kstep; const char* b3 = b2 + kstep;
      PG8_LDB(B0, 0, 0); PG8_SCHED; PG8_LDA(At, 0, 0); PG8_STAGE(PG8_SA(1, 1), a1 + hstep);
      PG8_WAIT_L(8); PG8_BAR; PG8_WAIT_L(0); PG8_MMA(0, 0, At, B0); PG8_BAR; PG8_SCHED;
      PG8_LDB(B1, 0, 1); PG8_STAGE(PG8_SB(0, 0), b2);
      PG8_BAR; PG8_WAIT_L(0); PG8_MMA(0, 1, At, B1); PG8_BAR;
      PG8_LDA(At, 0, 1); PG8_STAGE(PG8_SA(0, 0), a2);
      PG8_BAR; PG8_WAIT_L(0); PG8_MMA(1, 0, At, B0); PG8_BAR; PG8_SCHED;
      PG8_STAGE(PG8_SB(0, 1), b2 + hstep);
      PG8_WAIT_V(6); PG8_BAR; PG8_MMA(1, 1, At, B1); PG8_BAR;
      PG8_LDB(B0, 1, 0); PG8_SCHED; PG8_LDA(At, 1, 0); PG8_STAGE(PG8_SA(0, 1), a2 + hstep);
      PG8_WAIT_L(8); PG8_BAR; PG8_WAIT_L(0); PG8_MMA(0, 0, At, B0); PG8_BAR; PG8_SCHED;
      PG8_LDB(B1, 1, 1); PG8_STAGE(PG8_SB(1, 0), b3);
      PG8_BAR; PG8_WAIT_L(0); PG8_MMA(0, 1, At, B1); PG8_BAR;
      PG8_LDA(At, 1, 1); PG8_STAGE(PG8_SA(1, 0), a3);
      PG8_BAR; PG8_WAIT_L(0); PG8_MMA(1, 0, At, B0); PG8_BAR; PG8_SCHED;
      PG8_STAGE(PG8_SB(1, 1), b3 + hstep);
      PG8_WAIT_V(6); PG8_BAR; PG8_MMA(1, 1, At, B1); PG8_BAR;
    }
    if constexpr (!Epi::AFTER_DRAIN) E(acc, cur, wr, wc, fr, fq);
    if (!has_next) break;
#pragma unroll
    for (int a = 0; a < 2; ++a)
#pragma unroll
      for (int b = 0; b < 2; ++b)
#pragma unroll
        for (int m = 0; m < 4; ++m)
#pragma unroll
          for (int n = 0; n < 2; ++n) acc[a][b][m][n] = (f32x4){0.f, 0.f, 0.f, 0.f};
    cur = nxt; cA = nA; cB = nB; ++ui;
  }
  PG8_WAIT_V(0);
  if (wr == 0) PG8_BAR;
  PG8_BAR;
  if constexpr (Epi::AFTER_DRAIN) { if constexpr (I8) rescale(); E.fused(acc, cur, wr, wc, fr, fq, smem, wid, lane); }
#undef PG8_SA
#undef PG8_SB
#undef PG8_STAGE
#undef PG8_LDA
#undef PG8_LDB
#undef PG8_MMA
#undef PG8_WAIT_V
#undef PG8_WAIT_L
#undef PG8_BAR
#undef PG8_SCHED
}

struct EpiIn {
  static constexpr bool AFTER_DRAIN = false;
  bf16_t* P; const f32x2* RT; const float* SA; const float* SB;
  __device__ __forceinline__ void operator()(f32x4 (&acc)[2][2][4][2], const Unit& u, int wr, int wc, int fr, int fq) const {
    const int kind = u.pn >> 1;
    float sa[2][4]; f32x4 sb[2][2];
#pragma unroll
    for (int ai = 0; ai < 2; ++ai)
#pragma unroll
      for (int m = 0; m < 4; ++m) sa[ai][m] = SA[u.pm * 256 + ai * 128 + wr * 64 + m * 16 + fr];
#pragma unroll
    for (int bj = 0; bj < 2; ++bj)
#pragma unroll
      for (int n = 0; n < 2; ++n) sb[bj][n] = *(const f32x4*)(SB + u.pn * 256 + bj * 128 + wc * 32 + n * 16 + 4 * fq);
    const bool rot = (kind == 2 || kind == 3);
    f32x4 rtn[2];
    auto ld_rt = [&](int ai, int m) {
      const int pos = (u.pm * 256 + ai * 128 + wr * 64 + m * 16 + fr) & (SEQ - 1);
      const f32x4* rt = (const f32x4*)(RT + pos * 32 + 16 * (wc & 1) + 4 * fq);
      rtn[0] = rt[0]; rtn[1] = rt[1];
    };
    if (rot) ld_rt(0, 0);
#pragma unroll
    for (int ai = 0; ai < 2; ++ai)
#pragma unroll
      for (int m = 0; m < 4; ++m) {
        const int row = u.pm * 256 + ai * 128 + wr * 64 + m * 16 + fr;
        const f32x4 c01 = rtn[0], c23 = rtn[1];
        if (rot && (ai * 4 + m + 1 < 8)) ld_rt((ai * 4 + m + 1) >> 2, (ai * 4 + m + 1) & 3);
#pragma unroll
        for (int bj = 0; bj < 2; ++bj)
#pragma unroll
          for (int n = 0; n < 2; ++n) {
            const i32x4v iv = __builtin_bit_cast(i32x4v, acc[ai][bj][m][n]);
            acc[ai][bj][m][n] = (f32x4){(float)iv[0], (float)iv[1], (float)iv[2], (float)iv[3]} * sb[bj][n] * sa[ai][m];
          }
        if (kind <= 1) {
#pragma unroll
          for (int bj = 0; bj < 2; ++bj) {
            f32x4 v0 = acc[ai][bj][m][0], v1 = acc[ai][bj][m][1];
#pragma unroll
            for (int r = 0; r < 1; ++r) { v0 = gelu_tanh4(v0); v1 = gelu_tanh4(v1); }
            u32x4 w; w[0] = cvtpk(v0[0], v0[1]); w[1] = cvtpk(v0[2], v0[3]); w[2] = cvtpk(v1[0], v1[1]); w[3] = cvtpk(v1[2], v1[3]);
            *(u32x4*)(P + (size_t)row * DIN + u.pn * 256 + bj * 128 + wc * 32 + 8 * fq) = w;
          }
        } else if (kind <= 3) {
          const int j0 = 16 * (wc & 1) + 4 * fq;
          const float sc = (kind == 2) ? 0.18033688011112042f : 1.0f;
          const float cs[4] = {c01[0], c01[2], c23[0], c23[2]}, sn[4] = {c01[1], c01[3], c23[1], c23[3]};
#pragma unroll
          for (int bj = 0; bj < 2; ++bj) {
            f32x4 o1, o2;
#pragma unroll
            for (int r = 0; r < 4; ++r) {
              const float t1 = acc[ai][bj][m][0][r], t2 = acc[ai][bj][m][1][r];
              o1[r] = (t1 * cs[r] - t2 * sn[r]) * sc; o2[r] = (t2 * cs[r] + t1 * sn[r]) * sc;
            }
            bf16_t* dst = P + (size_t)row * DIN + u.pn * 256 + bj * 128 + (wc >> 1) * 64 + j0;
            u32x2 w; w[0] = cvtpk(o1[0], o1[1]); w[1] = cvtpk(o1[2], o1[3]); *(u32x2*)dst = w;
            w[0] = cvtpk(o2[0], o2[1]); w[1] = cvtpk(o2[2], o2[3]); *(u32x2*)(dst + 32) = w;
          }
        } else {
#pragma unroll
          for (int bj = 0; bj < 2; ++bj) {
            const f32x4 v0 = acc[ai][bj][m][0], v1 = acc[ai][bj][m][1];
            u32x4 w; w[0] = cvtpk(v0[0], v0[1]); w[1] = cvtpk(v0[2], v0[3]); w[2] = cvtpk(v1[0], v1[1]); w[3] = cvtpk(v1[2], v1[3]);
            *(u32x4*)(P + (size_t)row * DIN + u.pn * 256 + bj * 128 + wc * 32 + 8 * fq) = w;
          }
        }
      }
  }
};

struct EpiOut {
  static constexpr bool AFTER_DRAIN = false;
  const float* x; bf16_t* x1; const float* SA; const float* SB;
  __device__ __forceinline__ void operator()(f32x4 (&acc)[2][2][4][2], const Unit& u, int wr, int wc, int fr, int fq) const {
    f32x4 sbv[2][2];
#pragma unroll
    for (int bj = 0; bj < 2; ++bj)
#pragma unroll
      for (int n = 0; n < 2; ++n) sbv[bj][n] = *(const f32x4*)(SB + u.pn * 256 + bj * 128 + wc * 32 + n * 16 + 4 * fq);
#pragma unroll
    for (int ai = 0; ai < 2; ++ai) {
      f32x4 xv[4][2][2]; float sav[4];
#pragma unroll
      for (int m = 0; m < 4; ++m) sav[m] = SA[u.pm * 256 + ai * 128 + wr * 64 + m * 16 + fr];
#pragma unroll
      for (int m = 0; m < 4; ++m) {
        const size_t o = (size_t)(u.pm * 256 + ai * 128 + wr * 64 + m * 16 + fr) * DM + u.pn * 256 + wc * 32 + 4 * fq;
#pragma unroll
        for (int bj = 0; bj < 2; ++bj)
#pragma unroll
          for (int n = 0; n < 2; ++n) xv[m][bj][n] = __builtin_nontemporal_load((const f32x4*)(x + o + bj * 128 + n * 16));
      }
#pragma unroll
      for (int m = 0; m < 4; ++m) {
        const size_t o = (size_t)(u.pm * 256 + ai * 128 + wr * 64 + m * 16 + fr) * DM + u.pn * 256 + wc * 32 + 4 * fq;
#pragma unroll
        for (int bj = 0; bj < 2; ++bj)
#pragma unroll
          for (int n = 0; n < 2; ++n) {
            const i32x4v iv = __builtin_bit_cast(i32x4v, acc[ai][bj][m][n]);
            const f32x4 v = xv[m][bj][n] + (f32x4){(float)iv[0], (float)iv[1], (float)iv[2], (float)iv[3]} * sbv[bj][n] * sav[m]; u32x2 w; w[0] = cvtpk(v[0], v[1]); w[1] = cvtpk(v[2], v[3]); *(u32x2*)(x1 + o + bj * 128 + n * 16) = w; }
      }
    }
  }
};

__device__ __forceinline__ void top16_insert(float (&t)[16], float x) {
#pragma unroll
  for (int s = 15; s >= 1; --s) t[s] = __builtin_amdgcn_fmed3f(t[s - 1], t[s], x);
  t[0] = fmaxf(t[0], x);
}
struct EpiSel {
  static constexpr bool AFTER_DRAIN = true;
  unsigned short* SELE; float* SELG; const float* RS; const Params* prm; int useq;
  __device__ __forceinline__ void select_half(const float* Srow, float (&t)[16]) const {
#pragma unroll
    for (int s = 0; s < 16; ++s) t[s] = -__builtin_inff();
#pragma unroll 4
    for (int k4 = 0; k4 < 32; ++k4) {
      const f32x4 v = *(const f32x4*)(Srow + k4 * 4);
#pragma unroll
      for (int j = 0; j < 4; ++j) top16_insert(t, __uint_as_float((__float_as_uint(v[j]) & 0xffffff80u) | (unsigned)(k4 * 4 + j)));
    }
  }
  __device__ __forceinline__ void fused(f32x4 (&acc)[2][2][4][2], const Unit& u, int wr, int wc, int fr, int fq, unsigned char* smem, int wid, int lane) const {
    const int tid = wid * 64 + lane;
    float rsv[2][4];
#pragma unroll
    for (int ai = 0; ai < 2; ++ai)
#pragma unroll
      for (int m = 0; m < 4; ++m) rsv[ai][m] = RS[u.pm * 256 + ai * 128 + wr * 64 + m * 16 + fr];
    float* S = (float*)smem;
    float t1[16], t2[16];
#pragma unroll
    for (int p2 = 0; p2 < 2; ++p2) {
#pragma unroll
      for (int ai = 0; ai < 2; ++ai)
#pragma unroll
        for (int m = 0; m < 4; ++m)
#pragma unroll
          for (int n = 0; n < 2; ++n) *(f32x4*)(S + (ai * 128 + wr * 64 + m * 16 + fr) * 132 + wc * 32 + n * 16 + 4 * fq) = acc[ai][p2][m][n] * rsv[ai][m];
      __syncthreads();
      if (tid < 256) { if (p2 == 0) select_half(S + tid * 132, t1); else select_half(S + tid * 132, t2); }
      else {
#pragma unroll 1
        for (int j = 0; j < 2; ++j) convert_expert_row(*prm, useq * 16 + (wid - 4) * 4 + p2 * 2 + j, lane);
      }
      __syncthreads();
    }
    if (tid < 256) {
      unsigned char* IX = smem + 135168 + tid * 32;
#pragma unroll
      for (int s = 0; s < 16; ++s) { IX[s] = (unsigned char)(__float_as_uint(t1[s]) & 0x7f); IX[16 + s] = (unsigned char)(__float_as_uint(t2[s]) & 0x7f); }
      float c[16];
#pragma unroll
      for (int s = 0; s < 16; ++s) c[s] = -__builtin_inff();
#pragma unroll
      for (int i = 0; i < 16; ++i)
#pragma unroll
        for (int j = 0; j < 16; ++j)
          if ((i + 1) * (j + 1) <= 16) {
            const float a = __uint_as_float(__float_as_uint(t1[i]) & 0xffffff80u), b = __uint_as_float(__float_as_uint(t2[j]) & 0xffffff80u);
            top16_insert(c, __uint_as_float((__float_as_uint(a + b) & 0xffffff00u) | (unsigned)(i * 16 + j)));
          }
      float g[16]; float gs = 0.f; int e[16];
      const float cmax = __uint_as_float(__float_as_uint(c[0]) & 0xffffff00u);
#pragma unroll
      for (int s = 0; s < 16; ++s) {
        const unsigned cb = __float_as_uint(c[s]); const int id = (int)(cb & 0xff);
        g[s] = __expf(__uint_as_float(cb & 0xffffff00u) - cmax); gs += g[s];
        e[s] = (int)IX[id >> 4] * 128 + (int)IX[16 + (id & 15)];
      }
      const float inv = 1.0f / gs;
      const size_t o = ((size_t)(u.pm * 256 + tid) * 8 + u.pn) * 16;
#pragma unroll
      for (int s4 = 0; s4 < 4; ++s4) {
        *(f32x4*)(SELG + o + s4 * 4) = (f32x4){g[s4 * 4] * inv, g[s4 * 4 + 1] * inv, g[s4 * 4 + 2] * inv, g[s4 * 4 + 3] * inv};
        *(u32x2*)(SELE + o + s4 * 4) = (u32x2){(unsigned)e[s4 * 4] | ((unsigned)e[s4 * 4 + 1] << 16), (unsigned)e[s4 * 4 + 2] | ((unsigned)e[s4 * 4 + 3] << 16)};
      }
    }
    __syncthreads();
  }
};

__device__ __forceinline__ void tr_read2(unsigned a0, unsigned a1, s16x4& r0, s16x4& r1) {
  asm volatile("ds_read_b64_tr_b16 %0, %2\n\tds_read_b64_tr_b16 %1, %3\n\ts_waitcnt lgkmcnt(0)" : "=&v"(r0), "=&v"(r1) : "v"(a0), "v"(a1) : "memory");
}
__device__ __forceinline__ void tr_read8(unsigned a0, unsigned a1, s16x4 (&r)[8]) {
  asm volatile("ds_read_b64_tr_b16 %0, %8\n\tds_read_b64_tr_b16 %1, %9\n\tds_read_b64_tr_b16 %2, %8 offset:32\n\tds_read_b64_tr_b16 %3, %9 offset:32\n\t"
               "ds_read_b64_tr_b16 %4, %8 offset:64\n\tds_read_b64_tr_b16 %5, %9 offset:64\n\tds_read_b64_tr_b16 %6, %8 offset:96\n\tds_read_b64_tr_b16 %7, %9 offset:96\n\ts_waitcnt lgkmcnt(0)"
               : "=&v"(r[0]), "=&v"(r[1]), "=&v"(r[2]), "=&v"(r[3]), "=&v"(r[4]), "=&v"(r[5]), "=&v"(r[6]), "=&v"(r[7]) : "v"(a0), "v"(a1) : "memory");
}
constexpr size_t OFF_OP01 = OFF_H;
constexpr size_t OFF_OP2 = OFF_XN;
constexpr size_t OFF_LSE = OFF_XN + 64 * MB;
__device__ void attn_phase(const Params& p, unsigned char* smem) {
  THREAD_IDS const int fr = lane & 15, fq = lane >> 4;
  const bf16_t* P = (const bf16_t*)(p.ws + OFF_P);
  float* LSE = (float*)(p.ws + OFF_LSE);
  unsigned char* Ks = smem; unsigned char* Vs = smem + 36864;
  const unsigned vbase = (unsigned)(uintptr_t)(__attribute__((address_space(3))) unsigned char*)Vs;
  constexpr int NITEM = 32 * 8 * 3 * 16;
  u32x4 kst[4], vst[4];
  bf16x8 qn0, qn1, qc0, qc1;
  auto stage_load = [&](int item) {
    const int ii = item & 15, br = (item >> 4) % 3, bh = item / 48, b = bh >> 3, h = bh & 7;
    const int d = br == 0 ? 16 : (br == 1 ? 4 : 1), Lb = 2048 / d;
    const int r = br == 0 ? ii : (br == 1 ? (ii & 3) : 0), qb = br == 0 ? 0 : (br == 1 ? (ii >> 2) : ii);
    const int kbase = 128 * qb - 64;
#pragma unroll
    for (int i = 0; i < 4; ++i) {
      const int c = tid + 512 * i, j = c >> 3, part = c & 7;
      int kp = kbase + j; kp = kp < 0 ? 0 : (kp > Lb - 1 ? Lb - 1 : kp);
      const bf16_t* src = P + ((size_t)b * SEQ + r + d * kp) * DIN + h * 64 + part * 8;
      kst[i] = *(const u32x4*)(src + 1536); vst[i] = *(const u32x4*)(src + 2048);
    }
    const size_t tokq = (size_t)b * SEQ + r + d * (128 * qb + 16 * wid + fr);
    qn0 = *(const bf16x8*)(P + tokq * DIN + 1024 + h * 64 + 8 * fq); qn1 = *(const bf16x8*)(P + tokq * DIN + 1024 + h * 64 + 32 + 8 * fq);
  };
  auto stage_write = [&]() {
#pragma unroll
    for (int i = 0; i < 4; ++i) {
      const int c = tid + 512 * i, j = c >> 3, part = c & 7;
      *(u32x4*)(Ks + j * 144 + part * 16) = kst[i]; *(u32x4*)(Vs + j * 160 + part * 16) = vst[i];
    }
  };
  int item = blockIdx.x;
  __syncthreads();
  if (item < NITEM) { stage_load(item); stage_write(); }
  qc0 = qn0; qc1 = qn1;
  __syncthreads();
  for (; item < NITEM; item += gridDim.x) {
    const int nxt = item + gridDim.x;
    if (nxt < NITEM) stage_load(nxt);
    {
      const int ii = item & 15, br = (item >> 4) % 3, bh = item / 48, b = bh >> 3, h = bh & 7;
      const int d = br == 0 ? 16 : (br == 1 ? 4 : 1), Lb = 2048 / d;
      const int r = br == 0 ? ii : (br == 1 ? (ii & 3) : 0), qb = br == 0 ? 0 : (br == 1 ? (ii >> 2) : ii);
      const int qpos = 128 * qb + 16 * wid + fr;
      const size_t tokq = (size_t)b * SEQ + r + d * qpos;
      const bf16x8 qf0 = qc0, qf1 = qc1;
      const int kt0 = 8 * qb - 4 + wid;
      f32x4 S[10];
#pragma unroll
      for (int T = 0; T < 10; ++T) {
        const bool live = (T < 9) && (kt0 + T >= 0) && (16 * (kt0 + T) < Lb);
        if (live) {
          const int ti = (wid + T) < 15 ? (wid + T) : 15;
          const unsigned char* kr = Ks + (16 * ti + fr) * 144 + fq * 16;
          const bf16x8 k0 = *(const bf16x8*)kr, k1 = *(const bf16x8*)(kr + 64);
          S[T] = __builtin_amdgcn_mfma_f32_16x16x32_bf16(k0, qf0, (f32x4){0.f, 0.f, 0.f, 0.f}, 0, 0, 0);
          S[T] = __builtin_amdgcn_mfma_f32_16x16x32_bf16(k1, qf1, S[T], 0, 0, 0);
        } else S[T] = (f32x4){-1e30f, -1e30f, -1e30f, -1e30f};
      }
      float mx = -1e30f;
#pragma unroll
      for (int rg = 0; rg < 4; ++rg) {
        S[0][rg] = (4 * fq + rg - fr >= 0) ? S[0][rg] : -1e30f;
        S[8][rg] = (4 * fq + rg - fr <= 0) ? S[8][rg] : -1e30f;
      }
#pragma unroll
      for (int T = 0; T < 9; ++T)
#pragma unroll
        for (int rg = 0; rg < 4; ++rg) mx = fmaxf(mx, S[T][rg]);
      mx = max_x32(max_x16(mx));
      float l = 0.f;
#pragma unroll
      for (int T = 0; T < 10; ++T)
#pragma unroll
        for (int rg = 0; rg < 4; ++rg) { S[T][rg] = __builtin_amdgcn_exp2f(S[T][rg] - mx); l += S[T][rg]; }
      l = sum_x32(sum_x16(l));
      f32x4 O[4];
#pragma unroll
      for (int dt = 0; dt < 4; ++dt) O[dt] = (f32x4){0.f, 0.f, 0.f, 0.f};
#pragma unroll
      for (int pr = 0; pr < 5; ++pr) {
        const int T0 = 2 * pr, T1 = 2 * pr + 1;
        const bool live0 = (kt0 + T0 >= 0) && (16 * (kt0 + T0) < Lb), live1 = (T1 < 9) && (kt0 + T1 >= 0) && (16 * (kt0 + T1) < Lb);
        if (!(live0 || live1)) continue;
        const int t0i = (wid + T0) < 15 ? (wid + T0) : 15, t1i = (wid + T1) < 15 ? (wid + T1) : 15;
        u32x4 pw; pw[0] = cvtpk(S[T0][0], S[T0][1]); pw[1] = cvtpk(S[T0][2], S[T0][3]); pw[2] = cvtpk(S[T1][0], S[T1][1]); pw[3] = cvtpk(S[T1][2], S[T1][3]);
        const bf16x8 pf = __builtin_bit_cast(bf16x8, pw);
        const unsigned a0 = vbase + (16 * t0i + 4 * fq + (fr >> 2)) * 160 + 4 * (fr & 3) * 2;
        const unsigned a1 = vbase + (16 * t1i + 4 * fq + (fr >> 2)) * 160 + 4 * (fr & 3) * 2;
        s16x4 vr[8]; tr_read8(a0, a1, vr);
#pragma unroll
        for (int dt = 0; dt < 4; ++dt) {
          const s16x4 v0 = vr[2 * dt], v1 = vr[2 * dt + 1];
          bf16x8 vf; vf[0] = v0[0]; vf[1] = v0[1]; vf[2] = v0[2]; vf[3] = v0[3]; vf[4] = v1[0]; vf[5] = v1[1]; vf[6] = v1[2]; vf[7] = v1[3];
          O[dt] = __builtin_amdgcn_mfma_f32_16x16x32_bf16(vf, pf, O[dt], 0, 0, 0);
        }
      }
      const float inv = 1.0f / l;
      bf16_t* op = (br < 2 ? (bf16_t*)(p.ws + OFF_OP01) + (size_t)br * NTOK * 512 : (bf16_t*)(p.ws + OFF_OP2)) + tokq * 512 + h * 64 + 4 * fq;
#pragma unroll
      for (int dt = 0; dt < 4; ++dt) {
        const f32x4 o = O[dt] * inv;
        u32x2 w; w[0] = cvtpk(o[0], o[1]); w[1] = cvtpk(o[2], o[3]);
        *(u32x2*)(op + 16 * dt) = w;
      }
      if (fq == 0) LSE[((size_t)br * NTOK + tokq) * 8 + h] = mx + __builtin_amdgcn_logf(l);
    }
    __syncthreads();
    if (nxt < NITEM) stage_write();
    qc0 = qn0; qc1 = qn1;
    __syncthreads();
  }
}

__device__ void attn_merge_phase(const Params& p) {
  THREAD_IDS
  const float* LSE = (const float*)(p.ws + OFF_LSE);
  bf16_t* MIX = (bf16_t*)(p.ws + OFF_MIX);
  const f32x4 g0 = *(const f32x4*)(p.out_norm_b_g + lane * 8), g1 = *(const f32x4*)(p.out_norm_b_g + lane * 8 + 4);
  const int h = lane >> 3, tstep = gridDim.x * 8;
  float ln[3], scn; u32x4 an, bn, cn;
  auto ld = [&](int t) {
    ln[0] = LSE[((size_t)0 * NTOK + t) * 8 + h]; ln[1] = LSE[((size_t)1 * NTOK + t) * 8 + h]; ln[2] = LSE[((size_t)2 * NTOK + t) * 8 + h];
    an = *(const u32x4*)((const bf16_t*)(p.ws + OFF_OP01) + (size_t)t * 512 + lane * 8);
    bn = *(const u32x4*)((const bf16_t*)(p.ws + OFF_OP01) + ((size_t)NTOK + t) * 512 + lane * 8);
    cn = *(const u32x4*)((const bf16_t*)(p.ws + OFF_OP2) + (size_t)t * 512 + lane * 8);
    scn = ((const float*)(p.ws + OFF_SAM))[t];
  };
  ld(blockIdx.x * 8 + wid);
  for (int t = blockIdx.x * 8 + wid; t < NTOK; t += tstep) {
    const float l0 = ln[0], l1 = ln[1], l2 = ln[2];
    const u32x4 a = an, b = bn, c = cn; const float scale = scn;
    if (t + tstep < NTOK) ld(t + tstep);
    const float mx = fmaxf(l0, fmaxf(l1, l2));
    float w0 = __builtin_amdgcn_exp2f(l0 - mx), w1 = __builtin_amdgcn_exp2f(l1 - mx), w2 = __builtin_amdgcn_exp2f(l2 - mx);
    const float inv = 1.0f / (w0 + w1 + w2); w0 *= inv; w1 *= inv; w2 *= inv;
    float o[8]; float ss = 0.f;
#pragma unroll
    for (int j = 0; j < 4; ++j) {
      o[2 * j] = w0 * bf_lo(a[j]) + w1 * bf_lo(b[j]) + w2 * bf_lo(c[j]);
      o[2 * j + 1] = w0 * bf_hi(a[j]) + w1 * bf_hi(b[j]) + w2 * bf_hi(c[j]);
      ss += o[2 * j] * o[2 * j] + o[2 * j + 1] * o[2 * j + 1];
    }
    ss = wave_sum(ss);
    const float rs = rsqrtf(ss * (1.0f / 512.0f) + EPS);
    const float qs = scale > 0.f ? 1.0f / scale : 0.f;
    float vb[8];
#pragma unroll
    for (int j = 0; j < 8; ++j) vb[j] = fminf(fmaxf(o[j] * rs * (j < 4 ? g0[j & 3] : g1[j & 3]) * qs, -127.0f), 127.0f);
    u32x2 qb;
#pragma unroll
    for (int e = 0; e < 2; ++e)
      qb[e] = ((unsigned)__float2int_rn(vb[4 * e]) & 0xffu) | (((unsigned)__float2int_rn(vb[4 * e + 1]) & 0xffu) << 8) | (((unsigned)__float2int_rn(vb[4 * e + 2]) & 0xffu) << 16) | ((unsigned)__float2int_rn(vb[4 * e + 3]) << 24);
    *(u32x2*)(p.ws + OFF_MIX8 + (size_t)t * DM + 512 + lane * 8) = qb;
  }
}

__device__ __forceinline__ void tr_read8s(unsigned a0, s16x4 (&r)[8]) {
  asm volatile("ds_read_b64_tr_b16 %0, %8\n\tds_read_b64_tr_b16 %1, %8 offset:4224\n\tds_read_b64_tr_b16 %2, %8 offset:32\n\tds_read_b64_tr_b16 %3, %8 offset:4256\n\t"
               "ds_read_b64_tr_b16 %4, %8 offset:64\n\tds_read_b64_tr_b16 %5, %8 offset:4288\n\tds_read_b64_tr_b16 %6, %8 offset:96\n\tds_read_b64_tr_b16 %7, %8 offset:4320\n\ts_waitcnt lgkmcnt(0)"
               : "=&v"(r[0]), "=&v"(r[1]), "=&v"(r[2]), "=&v"(r[3]), "=&v"(r[4]), "=&v"(r[5]), "=&v"(r[6]), "=&v"(r[7]) : "v"(a0) : "memory");
}
__device__ void spatial_item(const Params& p, int item, unsigned char* smem) {
  THREAD_IDS const int fr = lane & 15, fq = lane >> 4;
  const bf16_t* P = (const bf16_t*)(p.ws + OFF_P);
  const bf16_t* WSP = (const bf16_t*)(p.ws + OFF_WSP);
  bf16_t* MIX = (bf16_t*)(p.ws + OFF_MIX);
  const size_t t0 = (size_t)item * 128;
  constexpr int YS = 1056;
  const unsigned ybase = (unsigned)(uintptr_t)(__attribute__((address_space(3))) unsigned char*)smem;
  __syncthreads();
  {
    const f32x4 g0 = *(const f32x4*)(p.ln_v_g + lane * 8), g1 = *(const f32x4*)(p.ln_v_g + lane * 8 + 4);
    const f32x4 b0 = *(const f32x4*)(p.ln_v_b + lane * 8), b1 = *(const f32x4*)(p.ln_v_b + lane * 8 + 4);
    for (int r4 = 0; r4 < 4; ++r4) {
      u32x4 w[4];
#pragma unroll
      for (int q = 0; q < 4; ++q) w[q] = *(const u32x4*)(P + (t0 + wid * 16 + r4 * 4 + q) * DIN + 512 + lane * 8);
      float v[4][8], s1[4], s2[4];
#pragma unroll
      for (int q = 0; q < 4; ++q) {
        s1[q] = 0.f; s2[q] = 0.f;
#pragma unroll
        for (int j = 0; j < 4; ++j) { v[q][2 * j] = bf_lo(w[q][j]); v[q][2 * j + 1] = bf_hi(w[q][j]); }
#pragma unroll
        for (int i = 0; i < 8; ++i) { s1[q] += v[q][i]; s2[q] += v[q][i] * v[q][i]; }
      }
#pragma unroll
      for (int q = 0; q < 4; ++q) { s1[q] = wave_sum(s1[q]); s2[q] = wave_sum(s2[q]); }
#pragma unroll
      for (int q = 0; q < 4; ++q) {
        const float mean = s1[q] * (1.0f / 512.0f), var = fmaxf(s2[q] * (1.0f / 512.0f) - mean * mean, 0.f), rs = rsqrtf(var + EPS);
        u32x4 o;
        o[0] = cvtpk((v[q][0] - mean) * rs * g0[0] + b0[0], (v[q][1] - mean) * rs * g0[1] + b0[1]); o[1] = cvtpk((v[q][2] - mean) * rs * g0[2] + b0[2], (v[q][3] - mean) * rs * g0[3] + b0[3]);
        o[2] = cvtpk((v[q][4] - mean) * rs * g1[0] + b1[0], (v[q][5] - mean) * rs * g1[1] + b1[1]); o[3] = cvtpk((v[q][6] - mean) * rs * g1[2] + b1[2], (v[q][7] - mean) * rs * g1[3] + b1[3]);
        *(u32x4*)(smem + (wid * 16 + r4 * 4 + q) * YS + lane * 16) = o;
      }
    }
  }
  __syncthreads();
  const size_t tp = t0 + wid * 16 + fr;
  float ss = 0.f;
  unsigned keep[8][4][2];
#pragma unroll
  for (int g = 0; g < 8; ++g) {
    bf16x8 bfr[4];
#pragma unroll
    for (int ks = 0; ks < 4; ++ks) bfr[ks] = *(const bf16x8*)(WSP + (size_t)(g * 128 + wid * 16 + fr) * 128 + 32 * ks + 8 * fq);
    const float bias = p.b_spatial[g * 128 + wid * 16 + fr];
    u32x2 uw[4];
#pragma unroll
    for (int ct = 0; ct < 4; ++ct) uw[ct] = *(const u32x2*)(P + tp * DIN + 64 * g + 16 * ct + 4 * fq);
    f32x4 acc[4];
#pragma unroll
    for (int ct = 0; ct < 4; ++ct) acc[ct] = (f32x4){0.f, 0.f, 0.f, 0.f};
#pragma unroll
    for (int ks = 0; ks < 4; ++ks) {
      const unsigned a0 = ybase + (32 * ks + 8 * fq + (fr >> 2)) * YS + (64 * g + 4 * (fr & 3)) * 2;
      s16x4 vr[8]; tr_read8s(a0, vr);
#pragma unroll
      for (int ct = 0; ct < 4; ++ct) {
        const s16x4 v0 = vr[2 * ct], v1 = vr[2 * ct + 1];
        bf16x8 af; af[0] = v0[0]; af[1] = v0[1]; af[2] = v0[2]; af[3] = v0[3]; af[4] = v1[0]; af[5] = v1[1]; af[6] = v1[2]; af[7] = v1[3];
        acc[ct] = __builtin_amdgcn_mfma_f32_16x16x32_bf16(af, bfr[ks], acc[ct], 0, 0, 0);
      }
    }
#pragma unroll
    for (int ct = 0; ct < 4; ++ct) {
      f32x4 a;
      a[0] = bf_lo(uw[ct][0]) * (acc[ct][0] + bias); a[1] = bf_hi(uw[ct][0]) * (acc[ct][1] + bias); a[2] = bf_lo(uw[ct][1]) * (acc[ct][2] + bias); a[3] = bf_hi(uw[ct][1]) * (acc[ct][3] + bias);
      ss += a[0] * a[0] + a[1] * a[1] + a[2] * a[2] + a[3] * a[3];
      keep[g][ct][0] = cvtpk(a[0], a[1]); keep[g][ct][1] = cvtpk(a[2], a[3]);
    }
  }
  ss = sum_x32(sum_x16(ss));
  const float rs = rsqrtf(ss * (1.0f / 512.0f) + EPS);
  float am = 0.f;
#pragma unroll
  for (int g = 0; g < 8; ++g)
#pragma unroll
    for (int ct = 0; ct < 4; ++ct) {
      const f32x4 gm = *(const f32x4*)(p.out_norm_a_g + 64 * g + 16 * ct + 4 * fq);
      am = fmaxf(am, fmaxf(fmaxf(fabsf(bf_lo(keep[g][ct][0]) * gm[0]), fabsf(bf_hi(keep[g][ct][0]) * gm[1])), fmaxf(fabsf(bf_lo(keep[g][ct][1]) * gm[2]), fabsf(bf_hi(keep[g][ct][1]) * gm[3]))));
    }
  am = max_x32(max_x16(am)) * rs;
  float gbm = 0.f;
  { const f32x4 b0 = *(const f32x4*)(p.out_norm_b_g + lane * 8), b1 = *(const f32x4*)(p.out_norm_b_g + lane * 8 + 4);
    gbm = wave_max(fmaxf(fmaxf(fmaxf(fabsf(b0[0]), fabsf(b0[1])), fmaxf(fabsf(b0[2]), fabsf(b0[3]))), fmaxf(fmaxf(fabsf(b1[0]), fabsf(b1[1])), fmaxf(fabsf(b1[2]), fabsf(b1[3]))))); }
  const float top = fmaxf(am, 4.0f * gbm), qs = top > 0.f ? 127.0f / top : 0.f;
  if (fq == 0) ((float*)(p.ws + OFF_SAM))[tp] = top * (1.0f / 127.0f);
#pragma unroll
  for (int g = 0; g < 8; ++g)
#pragma unroll
    for (int ct = 0; ct < 4; ++ct) {
      const int ch = 64 * g + 16 * ct + 4 * fq;
      const f32x4 gm = *(const f32x4*)(p.out_norm_a_g + ch);
      const float sc = rs * qs;
      const unsigned q = ((unsigned)__float2int_rn(bf_lo(keep[g][ct][0]) * gm[0] * sc) & 0xffu) | (((unsigned)__float2int_rn(bf_hi(keep[g][ct][0]) * gm[1] * sc) & 0xffu) << 8)
                       | (((unsigned)__float2int_rn(bf_lo(keep[g][ct][1]) * gm[2] * sc) & 0xffu) << 16) | ((unsigned)__float2int_rn(bf_hi(keep[g][ct][1]) * gm[3] * sc) << 24);
      *(unsigned*)(p.ws + OFF_MIX8 + tp * DM + ch) = q;
    }
  __syncthreads();
}

template <int NCH> __device__ void quant_weight_rows(const bf16_t* W, unsigned char* W8, float* SC, int N) {
  THREAD_IDS
  for (int r = blockIdx.x * 8 + wid; r < N; r += gridDim.x * 8) {
    u32x4 w[NCH]; float am = 0.f;
#pragma unroll
    for (int c = 0; c < NCH; ++c) {
      w[c] = *(const u32x4*)(W + (size_t)r * (512 * NCH) + c * 512 + lane * 8);
#pragma unroll
      for (int j = 0; j < 4; ++j) am = fmaxf(am, fmaxf(fabsf(bf_lo(w[c][j])), fabsf(bf_hi(w[c][j]))));
    }
    am = wave_max(am);
    const float qs = am > 0.f ? 127.0f / am : 0.f;
#pragma unroll
    for (int c = 0; c < NCH; ++c) {
      u32x2 q;
#pragma unroll
      for (int e = 0; e < 2; ++e)
        q[e] = ((unsigned)__float2int_rn(bf_lo(w[c][2 * e]) * qs) & 0xffu) | (((unsigned)__float2int_rn(bf_hi(w[c][2 * e]) * qs) & 0xffu) << 8) | (((unsigned)__float2int_rn(bf_lo(w[c][2 * e + 1]) * qs) & 0xffu) << 16) | ((unsigned)__float2int_rn(bf_hi(w[c][2 * e + 1]) * qs) << 24);
      *(u32x2*)(W8 + (size_t)r * (512 * NCH) + c * 512 + lane * 8) = q;
    }
    if (lane == 0) SC[r] = am * (1.0f / 127.0f);
  }
}

__device__ void phase_xn(const Params& p) {
  THREAD_IDS
  float* RS = (float*)(p.ws + OFF_RS);
  float* SX = (float*)(p.ws + OFF_SX);
  const int rstep = gridDim.x * 8;
  u32x4 wn[2];
  { const bf16_t* xr = (const bf16_t*)(p.ws + OFF_X1B) + (size_t)(blockIdx.x * 8 + wid) * DM; wn[0] = *(const u32x4*)(xr + lane * 8); wn[1] = *(const u32x4*)(xr + 512 + lane * 8); }
  for (int row = blockIdx.x * 8 + wid; row < NTOK; row += rstep) {
    f32x4 v[4]; float ss = 0.f;
    const u32x4 wc2[2] = {wn[0], wn[1]};
    if (row + rstep < NTOK) { const bf16_t* xr = (const bf16_t*)(p.ws + OFF_X1B) + (size_t)(row + rstep) * DM; wn[0] = *(const u32x4*)(xr + lane * 8); wn[1] = *(const u32x4*)(xr + 512 + lane * 8); }
#pragma unroll
    for (int hf = 0; hf < 2; ++hf) {
      const u32x4 w = wc2[hf];
      v[2 * hf] = (f32x4){bf_lo(w[0]), bf_hi(w[0]), bf_lo(w[1]), bf_hi(w[1])}; v[2 * hf + 1] = (f32x4){bf_lo(w[2]), bf_hi(w[2]), bf_lo(w[3]), bf_hi(w[3])};
    }
#pragma unroll
    for (int i = 0; i < 4; ++i) ss += v[i][0] * v[i][0] + v[i][1] * v[i][1] + v[i][2] * v[i][2] + v[i][3] * v[i][3];
    ss = wave_sum(ss);
    const float rs = rsqrtf(ss * (1.0f / DM) + EPS);
    if (lane == 0) RS[row] = rs;
    {
      float am = 0.f;
#pragma unroll
      for (int i = 0; i < 4; ++i) am = fmaxf(am, fmaxf(fmaxf(fabsf(v[i][0]), fabsf(v[i][1])), fmaxf(fabsf(v[i][2]), fabsf(v[i][3]))));
      am = wave_max(am);
      const float qs = am > 0.f ? 119.0f / am : 0.f, sx = am * (1.0f / 119.0f) * rs;
#pragma unroll
      for (int hf = 0; hf < 2; ++hf) {
        u32x2 q; int qsum = 0;
#pragma unroll
        for (int e = 0; e < 2; ++e) {
          const f32x4 a = v[2 * hf + e] * qs;
          const int q0 = __float2int_rn(a[0]), q1 = __float2int_rn(a[1]), q2 = __float2int_rn(a[2]), q3 = __float2int_rn(a[3]);
          qsum += q0 + q1 + q2 + q3;
          q[e] = ((unsigned)q0 & 0xffu) | (((unsigned)q1 & 0xffu) << 8) | (((unsigned)q2 & 0xffu) << 16) | ((unsigned)q3 << 24);
        }
        *(u32x2*)(p.ws + OFF_X8 + (size_t)row * DM + hf * 512 + lane * 8) = q;
        const float cs = sum_x16(sum16((float)qsum));
        if ((lane & 31) == 0) *(f32x2*)(SX + ((size_t)row * 4 + 2 * hf + (lane >> 5)) * 2) = (f32x2){sx, 0.5f * sx * cs};
      }
      if (lane == 0) ((float*)(p.ws + OFF_SA8))[row] = am * (1.0f / 119.0f);
    }
  }
}

__device__ __forceinline__ unsigned xcc_id() { return (unsigned)__builtin_amdgcn_s_getreg((3 << 11) | 20) & 7u; }
constexpr int ITEM_TOK = 16;
template <int NP, class F> __device__ __forceinline__ void run_queue(unsigned* qbase, F&& body) {
  THREAD_IDS
  const int myp = (int)xcc_id() & (NP - 1);
  int k = 0;
  unsigned idx = 0;
  if (lane == 0) idx = __hip_atomic_fetch_add(qbase + myp * 32, 1u, __ATOMIC_RELAXED, __HIP_MEMORY_SCOPE_AGENT);
  while (k < NP) {
    const int part = (myp + k) & (NP - 1);
    const unsigned cur = (unsigned)__builtin_amdgcn_readfirstlane((int)idx);
    if (cur >= (unsigned)(NTOK / ITEM_TOK)) {
      ++k;
      if (k < NP && lane == 0) idx = __hip_atomic_fetch_add(qbase + ((myp + k) & (NP - 1)) * 32, 1u, __ATOMIC_RELAXED, __HIP_MEMORY_SCOPE_AGENT);
      continue;
    }
    if (lane == 0) idx = __hip_atomic_fetch_add(qbase + part * 32, 1u, __ATOMIC_RELAXED, __HIP_MEMORY_SCOPE_AGENT);
    body(part, (int)cur);
  }
}

template <int CTRL> __device__ __forceinline__ int dppi(int x) { return __builtin_amdgcn_mov_dpp(x, CTRL, 0xf, 0xf, true); }
__device__ __forceinline__ int isum8(int s) { s += dppi<0xB1>(s); s += dppi<0x4E>(s); s += dppi<0x141>(s); return s; }
__device__ void phase_udot(const Params& p, int qoff) {
  THREAD_IDS const int g = lane >> 3, sub = lane & 7;
  const unsigned char* XQ = p.ws + OFF_X8;
  const f32x2* SX = (const f32x2*)(p.ws + OFF_SX);
  const unsigned short* SELE = (const unsigned short*)(p.ws + OFF_SELE);
  unsigned* PD = (unsigned*)(p.ws + OFF_PD);
  run_queue<4>((unsigned*)(p.ws + OFF_Q) + qoff, [&](int part, int idx) {
    const unsigned char* EU = p.ws + OFF_EU + (size_t)part * SLICE + sub * 16;
    const int t0 = idx * ITEM_TOK;
    u32x4 ev[3][2], xb0[2], xb1[2], rw[2][16]; f32x2 sxv[2];
    auto ld_e = [&](int tt) {
#pragma unroll
      for (int i = 0; i < 2; ++i) ev[tt % 3][i] = *(const u32x4*)(SELE + (size_t)(t0 + tt) * 128 + g * 16 + 8 * i);
    };
    auto ld_x = [&](int tt) {
      const unsigned char* xr = XQ + (size_t)(t0 + tt) * DM + part * 256 + sub * 32;
      xb0[tt & 1] = *(const u32x4*)xr; xb1[tt & 1] = *(const u32x4*)(xr + 16);
      sxv[tt & 1] = SX[(size_t)(t0 + tt) * 4 + part];
    };
    auto ld_rows = [&](int tt) {
#pragma unroll
      for (int b = 0; b < 16; ++b) rw[tt & 1][b] = *(const u32x4*)(EU + (size_t)((ev[tt % 3][b >> 3][(b >> 1) & 3] >> (16 * (b & 1))) & 0xffffu) * 128);
    };
    auto reduce = [&](int tt) {
      unsigned xh[4], xl[4];
#pragma unroll
      for (int j = 0; j < 4; ++j) {
        const unsigned w0 = j < 2 ? xb0[tt & 1][2 * j] : xb1[tt & 1][2 * j - 4], w1 = j < 2 ? xb0[tt & 1][2 * j + 1] : xb1[tt & 1][2 * j - 3];
        const unsigned v0 = ((w0 ^ 0x80808080u) + 0x08080808u) ^ 0x88888888u, v1 = ((w1 ^ 0x80808080u) + 0x08080808u) ^ 0x88888888u;
        xl[j] = (v0 & 0x0f0f0f0fu) | ((v1 & 0x0f0f0f0fu) << 4);
        xh[j] = ((v0 >> 4) & 0x0f0f0f0fu) | (v1 & 0xf0f0f0f0u);
      }
      int k0 = 0, k1 = 0;
#pragma unroll
      for (int b = 0; b < 16; ++b) {
        int dh = 0, dl = 0;
#pragma unroll
        for (int j = 0; j < 4; ++j) { dh = __builtin_amdgcn_sdot8((int)rw[tt & 1][b][j], (int)xh[j], dh, false); dl = __builtin_amdgcn_sdot8((int)rw[tt & 1][b][j], (int)xl[j], dl, false); }
        const int d = isum8(dh * 16 + dl);
        if (b & 1) k1 = (sub == (b >> 1)) ? d : k1; else k0 = (sub == (b >> 1)) ? d : k0;
      }
      PD[((size_t)(t0 + tt) * 4 + part) * 64 + g * 8 + sub] = cvtpk((float)k0 * sxv[tt & 1][0] + sxv[tt & 1][1], (float)k1 * sxv[tt & 1][0] + sxv[tt & 1][1]);
    };
    ld_e(0); ld_e(1); ld_e(2); ld_x(0); ld_rows(0);
#pragma unroll
    for (int tt = 0; tt < ITEM_TOK; ++tt) {
      if (tt + 1 < ITEM_TOK) { ld_rows(tt + 1); ld_x(tt + 1); }
      if (tt + 3 < ITEM_TOK) ld_e(tt + 3);
      reduce(tt);
    }
  });
}

__device__ __forceinline__ unsigned quant_coef(float c, unsigned E) {
  const float x = fabsf(c) * __uint_as_float((255u - E) << 23);
  const unsigned m = x < 0.25f ? 0u : x < 0.75f ? 1u : x < 1.25f ? 2u : x < 1.75f ? 3u : x < 2.5f ? 4u : x < 3.5f ? 5u : 6u;
  return ((E - 1u) << 8) | m | ((__float_as_uint(c) >> 28) & 8u);
}
__device__ void phase_coef(const Params& p) {
  const unsigned* SELE2 = (const unsigned*)(p.ws + OFF_SELE);
  const f32x2* SELG2 = (const f32x2*)(p.ws + OFF_SELG);
  const unsigned* PD = (const unsigned*)(p.ws + OFF_PD);
  const f32x2* SCL = (const f32x2*)(p.ws + OFF_SCL);
  const f32x4* SCLU = (const f32x4*)(p.ws + OFF_SCLU);
  unsigned* CQ = (unsigned*)(p.ws + OFF_CQ);
  THREAD_IDS
  const size_t istep = (size_t)gridDim.x * NTHREADS, iend = (size_t)NTOK * 64;
  unsigned pdn[4], e2n; f32x2 gtn;
  auto ld = [&](size_t i) {
    const size_t t = i >> 6; const int sp = (int)(i & 63);
#pragma unroll
    for (int q = 0; q < 4; ++q) pdn[q] = PD[(t * 4 + q) * 64 + sp];
    e2n = SELE2[i]; gtn = SELG2[i];
  };
  size_t i = (size_t)blockIdx.x * NTHREADS + tid;
  if (i < iend) ld(i);
  for (; i < iend; i += istep) {
    unsigned pd[4];
#pragma unroll
    for (int q = 0; q < 4; ++q) pd[q] = pdn[q];
    const unsigned e2 = e2n; const f32x2 gt = gtn;
    const float sv0 = SCL[e2 & 0xffffu][1], sv1 = SCL[e2 >> 16][1];
    const f32x4 su0 = SCLU[e2 & 0xffffu], su1 = SCLU[e2 >> 16];
    if (i + istep < iend) ld(i + istep);
    float s0 = 0.f, s1 = 0.f;
#pragma unroll
    for (int q = 0; q < 4; ++q) { s0 += bf_lo(pd[q]) * su0[q]; s1 += bf_hi(pd[q]) * su1[q]; }
    const float c0 = gt[0] * gelu_tanh(s0) * sv0, c1 = gt[1] * gelu_tanh(s1) * sv1;
    const unsigned e0 = (__float_as_uint(c0) >> 23) & 255u, e1 = (__float_as_uint(c1) >> 23) & 255u;
    const unsigned E0 = max(max(e0, (unsigned)dppi<0x128>((int)e0)), 1u), E1 = max(max(e1, (unsigned)dppi<0x128>((int)e1)), 1u);
    CQ[i] = quant_coef(c0, E0) | (quant_coef(c1, E1) << 16);
  }
}

__device__ void phase_vsum(const Params& p) {
  THREAD_IDS const int g = lane >> 3, sub = lane & 7, kg = lane >> 4;
  const unsigned short* SELE = (const unsigned short*)(p.ws + OFF_SELE);
  const unsigned char* CQ = p.ws + OFF_CQ;
  float* SS = (float*)(p.ws + OFF_SS);
  const bool lo8 = (lane & 8) == 0;
  const int jsh = 4 * (lane & 7);
  int one_scale = 0x7f7f7f7f; asm volatile("" : "+v"(one_scale));
  run_queue<4>((unsigned*)(p.ws + OFF_Q) + 8 * 32, [&](int part, int idx) {
    const unsigned char* EV = p.ws + OFF_EV + (size_t)part * SLICE + sub * 16;
    const int t0 = idx * ITEM_TOK;
    u32x4 ev[3][2], rw[2][16], ca[2][2], cb[2][2];
    auto ld_e = [&](int tt) {
#pragma unroll
      for (int i = 0; i < 2; ++i) ev[tt % 3][i] = *(const u32x4*)(SELE + (size_t)(t0 + tt) * 128 + g * 16 + 8 * i);
    };
    auto ld_c = [&](int tt) {
      const unsigned char* c = CQ + (size_t)(t0 + tt) * 256 + kg * 64;
      ca[tt & 1][0] = *(const u32x4*)c; ca[tt & 1][1] = *(const u32x4*)(c + 16); cb[tt & 1][0] = *(const u32x4*)(c + 32); cb[tt & 1][1] = *(const u32x4*)(c + 48);
    };
    auto ld_rows = [&](int tt) {
#pragma unroll
      for (int b = 0; b < 16; ++b) rw[tt & 1][b] = *(const u32x4*)(EV + (size_t)((ev[tt % 3][b >> 3][(b >> 1) & 3] >> (16 * (b & 1))) & 0xffffu) * 128);
    };
    auto reduce = [&](int tt) {
      const int t = t0 + tt;
      f32x4 acc0 = (f32x4){0.f, 0.f, 0.f, 0.f}, acc1 = acc0, acc2 = acc0, acc3 = acc0;
#pragma unroll
      for (int b = 0; b < 16; ++b) {
        const u32x4 w = rw[tt & 1][b];
        const unsigned qa = ca[tt & 1][b >> 3][(b >> 1) & 3] >> (16 * (b & 1)), qb = cb[tt & 1][b >> 3][(b >> 1) & 3] >> (16 * (b & 1));
        const unsigned da = (qa & 15u) << jsh, db = (qb & 15u) << jsh;
        const int sc = (int)(((qa >> 8) & 255u) * 0x01010101u);
        const i32x8v B = {(int)(lo8 ? da : 0u), (int)(lo8 ? 0u : da), (int)(lo8 ? db : 0u), (int)(lo8 ? 0u : db), 0, 0, 0, 0};
        const i32x8v A0 = {(int)(lo8 ? w[0] : 0u), (int)(lo8 ? w[1] : 0u), (int)(lo8 ? 0u : w[0]), (int)(lo8 ? 0u : w[1]), 0, 0, 0, 0};
        const i32x8v A1 = {(int)(lo8 ? w[2] : 0u), (int)(lo8 ? w[3] : 0u), (int)(lo8 ? 0u : w[2]), (int)(lo8 ? 0u : w[3]), 0, 0, 0, 0};
        if (b & 1) {
          acc2 = __builtin_amdgcn_mfma_scale_f32_16x16x128_f8f6f4(A0, B, acc2, 4, 4, 0, one_scale, 0, sc);
          acc3 = __builtin_amdgcn_mfma_scale_f32_16x16x128_f8f6f4(A1, B, acc3, 4, 4, 0, one_scale, 0, sc);
        } else {
          acc0 = __builtin_amdgcn_mfma_scale_f32_16x16x128_f8f6f4(A0, B, acc0, 4, 4, 0, one_scale, 0, sc);
          acc1 = __builtin_amdgcn_mfma_scale_f32_16x16x128_f8f6f4(A1, B, acc1, 4, 4, 0, one_scale, 0, sc);
        }
      }
      acc0 += acc2; acc1 += acc3;
      float r[4];
#pragma unroll
      for (int q = 0; q < 4; ++q) {
        const auto sw = __builtin_amdgcn_permlane32_swap(__float_as_uint(acc0[q]), __float_as_uint(acc1[q]), false, false);
        r[q] = __uint_as_float(sw[0]) + __uint_as_float(sw[1]);
      }
      {
        const int d0 = part * 256 + ((lane >> 4) & 1) * 128 + (lane >> 5) * 16 + (lane & 15);
        const bf16_t* x1 = (const bf16_t*)(p.ws + OFF_X1B) + (size_t)t * DM + d0;
        float v[4], pv[4], ss = 0.f;
#pragma unroll
        for (int q = 0; q < 4; ++q) { v[q] = __uint_as_float((unsigned)x1[32 * q] << 16) + r[q]; ss += v[q] * v[q]; pv[q] = dppf<0xB1>(v[q]); }
        const bool odd = (lane & 1) != 0;
        unsigned* o = (unsigned*)((bf16_t*)(p.ws + OFF_X2B) + (size_t)t * DM + (d0 & ~1) + (odd ? 64 : 0));
        o[0] = cvtpk(odd ? pv[2] : v[0], odd ? v[2] : pv[0]);
        o[16] = cvtpk(odd ? pv[3] : v[1], odd ? v[3] : pv[1]);
        ss = wave_sum(ss);
        if (lane == 0) atomicAdd(SS + t, ss);
      }
    };
    ld_e(0); ld_e(1); ld_e(2); ld_c(0); ld_rows(0);
#pragma unroll
    for (int tt = 0; tt < ITEM_TOK; ++tt) {
      if (tt + 1 < ITEM_TOK) { ld_rows(tt + 1); ld_c(tt + 1); }
      if (tt + 3 < ITEM_TOK) ld_e(tt + 3);
      reduce(tt);
    }
  });
}

__device__ void phase_final(const Params& p) {
  THREAD_IDS
  const float* SS = (const float*)(p.ws + OFF_SS);
  f32x4 gf[4];
#pragma unroll
  for (int i = 0; i < 4; ++i) gf[i] = *(const f32x4*)(p.final_norm_g + i * 256 + lane * 4);
  const int tstep = gridDim.x * 8;
  const bf16_t* X2 = (const bf16_t*)(p.ws + OFF_X2B);
  u32x2 vn[4]; float ssn;
  { const int t0 = blockIdx.x * 8 + wid; ssn = SS[t0];
#pragma unroll
    for (int i = 0; i < 4; ++i) vn[i] = *(const u32x2*)(X2 + (size_t)t0 * DM + i * 256 + lane * 4); }
  for (int t = blockIdx.x * 8 + wid; t < NTOK; t += tstep) {
    const float rs = rsqrtf(ssn * (1.0f / DM) + EPS);
    f32x4 v[4];
#pragma unroll
    for (int i = 0; i < 4; ++i) v[i] = (f32x4){bf_lo(vn[i][0]), bf_hi(vn[i][0]), bf_lo(vn[i][1]), bf_hi(vn[i][1])};
    if (t + tstep < NTOK) { ssn = SS[t + tstep];
#pragma unroll
      for (int i = 0; i < 4; ++i) vn[i] = *(const u32x2*)(X2 + (size_t)(t + tstep) * DM + i * 256 + lane * 4); }
    float* xr = p.out + (size_t)t * DM;
#pragma unroll
    for (int i = 0; i < 4; ++i) *(f32x4*)(xr + i * 256 + lane * 4) = v[i] * gf[i] * rs;
  }
}

#define XB_TMO      128
#define XB_XCNT(j)  (256  + 64 * (j))
#define XB_XSUB(j)  (1280 + 64 * (j))
#define XB_XGEN(j)  (2304 + 64 * (j))
#define XB_TOP      3328
#define XB_TOPGEN   3392
#define XCD_BAR_WORDS 3456
#define XB_SPIN_CAP (1u << 18)
#define LAS __attribute__((address_space(3)))
__device__ __forceinline__ unsigned xb_ld(unsigned* p)              { return __hip_atomic_load(p, __ATOMIC_RELAXED, __HIP_MEMORY_SCOPE_AGENT); }
__device__ __forceinline__ unsigned xb_add(unsigned* p, unsigned v) { return __hip_atomic_fetch_add(p, v, __ATOMIC_RELAXED, __HIP_MEMORY_SCOPE_AGENT); }
__device__ __forceinline__ unsigned xb_xcc_id() { return (unsigned)__builtin_amdgcn_s_getreg((3 << 11) | 20) & 0xFu; }
#define XB_SPIN(cond, bar) do { unsigned _sp = 0; while (cond) { __builtin_amdgcn_s_sleep(1); \
    if ((++_sp & 255u) == 0u) { if (xb_ld(&(bar)[XB_TMO])) break; if (_sp > XB_SPIN_CAP) { atomicAdd(&(bar)[XB_TMO], 1u); break; } } } } while (0)
struct XcdBarrier { unsigned* bar; unsigned x; volatile LAS unsigned* st; };
__device__ __forceinline__ XcdBarrier xcd_barrier_post(unsigned* bar, volatile LAS unsigned* st) {
    XcdBarrier b; b.bar = bar; b.x = xb_xcc_id(); b.st = st;
    if (threadIdx.x == 0) (void)xb_add(&bar[XB_XCNT(b.x)], 1u);
    return b;
}
__device__ __forceinline__ void xcd_barrier_complete(unsigned* bar, unsigned x, unsigned& nloc, unsigned& nx) {
    const unsigned G = gridDim.x * gridDim.y * gridDim.z;
    unsigned sum, cnt, mine, sp = 0u;
    for (;;) {
        sum = 0u; cnt = 0u; mine = 0u;
#pragma unroll
        for (unsigned j = 0; j < 16; ++j) { const unsigned c = xb_ld(&bar[XB_XCNT(j)]); sum += c; cnt += (c > 0u) ? 1u : 0u; mine = (j == x) ? c : mine; }
        if (sum == G) break;
        __builtin_amdgcn_s_sleep(1);
        if ((++sp & 255u) == 0u) { if (xb_ld(&bar[XB_TMO])) break; if (sp > XB_SPIN_CAP) { atomicAdd(&bar[XB_TMO], 1u); break; } }
    }
    nloc = mine > 0u ? mine : 1u; nx = cnt > 0u ? cnt : 1u;
}
__device__ __forceinline__ void xcd_barrier(const XcdBarrier& b) {
    asm volatile("s_waitcnt vmcnt(0)" ::: "memory");
    __syncthreads();
    if (threadIdx.x == 0) {
        unsigned* bar = b.bar;
        __builtin_amdgcn_s_waitcnt(0);
        unsigned nloc = b.st[0], nx = b.st[1];
        if (nloc == 0u) { xcd_barrier_complete(bar, b.x, nloc, nx); b.st[0] = nloc; b.st[1] = nx; }
        const unsigned old = xb_add(&bar[XB_XSUB(b.x)], 1u);
        const unsigned gen = old / nloc;
        if (old + 1u == (gen + 1u) * nloc) {
            __builtin_amdgcn_fence(__ATOMIC_RELEASE, "agent");
            asm volatile("s_waitcnt vmcnt(0)" ::: "memory");
            const unsigned og = xb_add(&bar[XB_TOP], 1u);
            const unsigned tg = og / nx;
            if (og + 1u == (tg + 1u) * nx) xb_add(&bar[XB_TOPGEN], 1u);
            else XB_SPIN(xb_ld(&bar[XB_TOPGEN]) == tg, bar);
            __builtin_amdgcn_fence(__ATOMIC_ACQUIRE, "agent");
            xb_add(&bar[XB_XGEN(b.x)], 1u);
            asm volatile("s_waitcnt vmcnt(0)" ::: "memory");
        } else {
            XB_SPIN(xb_ld(&bar[XB_XGEN(b.x)]) == gen, bar);
            __builtin_amdgcn_fence(__ATOMIC_ACQUIRE, "agent");
            asm volatile("s_waitcnt vmcnt(0)" ::: "memory");
        }
    }
    __syncthreads();
}

#ifndef PHASES
#define PHASES 0x7f
#endif
#ifndef DUP
#define DUP 0
#endif
__global__ void __launch_bounds__(NTHREADS) fwd_megakernel(Params p) {
  cg::grid_group grid = cg::this_grid();
  extern __shared__ __attribute__((aligned(16))) unsigned char smem[];
  unsigned char* ws = p.ws;
  unsigned* bar = (unsigned*)(ws + OFF_BAR);
  volatile LAS unsigned* st = (volatile LAS unsigned*)(LAS unsigned char*)(smem + 143360);
  if (blockIdx.x == 0) for (int i = threadIdx.x; i < XCD_BAR_WORDS; i += NTHREADS) bar[i] = 0u;
  if (threadIdx.x == 0) { st[0] = 0u; st[1] = 0u; }
#if PHASES & 1
  for (int rep = 0; rep < 1 + ((DUP >> 0) & 1); ++rep) { phase_prep(p, smem); __syncthreads(); }
#endif
  grid.sync();
  const XcdBarrier xb = xcd_barrier_post(bar, st);
  quant_weight_rows<2>((const bf16_t*)(ws + OFF_WIN), ws + OFF_WIN8, (float*)(ws + OFF_WSC) + 2048, 2560);
  quant_weight_rows<2>((const bf16_t*)(ws + OFF_WQ), ws + OFF_WQ8, (float*)(ws + OFF_WSC), 2048);
  quant_weight_rows<2>((const bf16_t*)(ws + OFF_WOUT), ws + OFF_WOUT8, (float*)(ws + OFF_WSC) + 4608, 1024);
  xcd_barrier(xb);
#if PHASES & 2
  for (int rep = 0; rep < 1 + ((DUP >> 1) & 1); ++rep)
  { EpiIn e{(bf16_t*)(ws + OFF_P), (const f32x2*)(ws + OFF_RT), (const float*)(ws + OFF_SAH), (const float*)(ws + OFF_WSC) + 2048}; StaticOrder so; so.init(NTOK, DIN, gridDim.x, blockIdx.x);
    gemm_phase<EpiIn, StaticOrder, true>(smem, (const bf16_t*)(ws + OFF_H8), (const bf16_t*)(ws + OFF_WIN8), DM / 2, so, e, (const float*)(ws + OFF_SAH), (const float*)(ws + OFF_WSC) + 2048); }
#endif
  xcd_barrier(xb);
#if PHASES & 4
  for (int rep = 0; rep < 1 + ((DUP >> 8) & 1); ++rep) attn_phase(p, smem);
  for (int rep = 0; rep < 1 + ((DUP >> 9) & 1); ++rep)
    for (int item = blockIdx.x; item < 512; item += gridDim.x) spatial_item(p, item, smem);
  xcd_barrier(xb);
  for (int rep = 0; rep < 1 + ((DUP >> 10) & 1); ++rep) attn_merge_phase(p);
#endif
  xcd_barrier(xb);
#if PHASES & 8
  for (int rep = 0; rep < 1 + ((DUP >> 3) & 1); ++rep)
  { EpiOut e{p.x, (bf16_t*)(ws + OFF_X1B), (const float*)(ws + OFF_SAM), (const float*)(ws + OFF_WSC) + 4608}; StaticOrder so; so.init(NTOK, DM, gridDim.x, blockIdx.x);
    gemm_phase<EpiOut, StaticOrder, true>(smem, (const bf16_t*)(ws + OFF_MIX8), (const bf16_t*)(ws + OFF_WOUT8), DM / 2, so, e); }
#endif
  xcd_barrier(xb);
#if PHASES & 16
  for (int rep = 0; rep < 1 + ((DUP >> 4) & 1); ++rep) phase_xn(p);
#endif
  xcd_barrier(xb);
#if PHASES & 32
  for (int rep = 0; rep < 1 + ((DUP >> 5) & 1); ++rep)
  { EpiSel e{(unsigned short*)(ws + OFF_SELE), (float*)(ws + OFF_SELG), (const float*)(ws + OFF_RS), &p, 0}; StaticOrder so; so.init(NTOK, 2048, gridDim.x, blockIdx.x);
    OneUnit one;
    for (int i = 0; so.next(i, one.u); ++i) { e.useq = i * (int)gridDim.x + (int)blockIdx.x; gemm_phase<EpiSel, OneUnit, true>(smem, (const bf16_t*)(ws + OFF_X8), (const bf16_t*)(ws + OFF_WQ8), DM / 2, one, e, (const float*)(ws + OFF_SA8), (const float*)(ws + OFF_WSC)); } }
#endif
  xcd_barrier(xb);
#if PHASES & 64
  phase_udot(p, 0);
#if DUP & 4096
  phase_udot(p, 512);
#endif
  xcd_barrier(xb);
  phase_coef(p);
  xcd_barrier(xb);
  phase_vsum(p);
  xcd_barrier(xb);
  phase_final(p);
#endif
}

extern "C" void kernel_launch(void* const* d_in, const int* in_sizes, int n_in, void* d_out, int out_size, void* d_ws, size_t ws_size, hipStream_t stream) {
  static int grid_blocks = 0;
  if (!grid_blocks) {
    if (hipFuncSetAttribute((const void*)fwd_megakernel, hipFuncAttributeMaxDynamicSharedMemorySize, LDS_BYTES) != hipSuccess) { fprintf(stderr, "hipFuncSetAttribute failed\n"); }
    int dev = 0, cus = 0, per_cu = 0;
    (void)hipGetDevice(&dev);
    (void)hipDeviceGetAttribute(&cus, hipDeviceAttributeMultiprocessorCount, dev);
    (void)hipOccupancyMaxActiveBlocksPerMultiprocessor(&per_cu, (const void*)fwd_megakernel, NTHREADS, LDS_BYTES);
    if (per_cu < 1) { fprintf(stderr, "occupancy query says 0 blocks/CU\n"); per_cu = 1; }
    grid_blocks = cus;
  }
  if (ws_size < WS_NEED) { fprintf(stderr, "workspace too small: %zu < %zu\n", ws_size, WS_NEED); return; }
  Params p{};
  p.x = (const float*)d_in[0]; p.norm1_g = (const float*)d_in[1]; p.w_in = (const float*)d_in[2]; p.ln_v_g = (const float*)d_in[3]; p.ln_v_b = (const float*)d_in[4];
  p.w_spatial = (const float*)d_in[5]; p.b_spatial = (const float*)d_in[6]; p.out_norm_a_g = (const float*)d_in[7]; p.out_norm_b_g = (const float*)d_in[8];
  p.w_out = (const float*)d_in[9]; p.norm2_g = (const float*)d_in[10]; p.w_query = (const float*)d_in[11]; p.sub_keys = (const float*)d_in[12];
  p.expert_u = (const float*)d_in[13]; p.expert_v = (const float*)d_in[14]; p.final_norm_g = (const float*)d_in[15];
  p.out = (float*)d_out; p.ws = (unsigned char*)d_ws;
  void* args[] = {&p};
  hipError_t e = hipLaunchCooperativeKernel((void*)fwd_megakernel, dim3(grid_blocks), dim3(NTHREADS), args, LDS_BYTES, stream);
  if (e != hipSuccess) fprintf(stderr, "cooperative launch failed: %s (grid %d)\n", hipGetErrorString(e), grid_blocks);
}
```

```cpp
#include <hip/hip_runtime.h>
#include <hip/hip_cooperative_groups.h>
#include <cstdio>
#include <cstdint>
namespace cg = cooperative_groups;

typedef unsigned short bf16_t;
typedef short bf16x8 __attribute__((ext_vector_type(8)));
typedef short s16x4 __attribute__((ext_vector_type(4)));
typedef float f32x4 __attribute__((ext_vector_type(4)));
typedef int i32x8v __attribute__((ext_vector_type(8)));
typedef float f32x2 __attribute__((ext_vector_type(2)));
typedef unsigned u32x4 __attribute__((ext_vector_type(4)));
typedef unsigned u32x2 __attribute__((ext_vector_type(2)));
typedef int i32x4v __attribute__((ext_vector_type(4)));
typedef __bf16 bf16x2v __attribute__((ext_vector_type(2)));

constexpr int NTOK = 65536, SEQ = 2048, DM = 1024, DIN = 2560, NEXP = 16384;
constexpr float EPS = 1e-6f;
constexpr int NTHREADS = 512;
constexpr int LDS_BYTES = 143360 + 16;

constexpr size_t MB = 1024 * 1024;
constexpr size_t OFF_RT = 0;
constexpr size_t OFF_WIN = 1 * MB;
constexpr size_t OFF_WOUT = 6 * MB;
constexpr size_t OFF_WQ = 8 * MB;
constexpr size_t OFF_SK = 12 * MB;
constexpr size_t OFF_WSP = 12 * MB + 65536;
constexpr size_t OFF_EU = 13 * MB;
constexpr size_t OFF_EV = 45 * MB;
constexpr size_t OFF_SCL = 76 * MB;
constexpr size_t OFF_SCLU = 76 * MB + 262144;
constexpr size_t OFF_H = 77 * MB;
constexpr size_t OFF_MIX = 205 * MB;
constexpr size_t OFF_XN = 333 * MB;
constexpr size_t OFF_P = 461 * MB;
constexpr size_t OFF_SELE = 781 * MB;
constexpr size_t OFF_SELG = 813 * MB;
constexpr size_t OFF_XQ = OFF_H;
constexpr size_t OFF_SX = OFF_H + 64 * MB;
constexpr size_t OFF_PD = OFF_P;
constexpr size_t OFF_X2B = OFF_MIX;
constexpr size_t OFF_CQ = OFF_P + 64 * MB;
constexpr size_t OFF_SS = 845 * MB;
constexpr size_t OFF_Q = 845 * MB + 262144;
constexpr size_t OFF_RS = 845 * MB + 393216;
constexpr size_t OFF_BAR = 845 * MB + 786432;
constexpr size_t OFF_X1B = 846 * MB;
constexpr size_t OFF_X8 = OFF_XN;
constexpr size_t OFF_SA8 = OFF_XN + 64 * MB;
constexpr size_t OFF_WQ8 = 975 * MB;
constexpr size_t OFF_WIN8 = 977 * MB;
constexpr size_t OFF_WOUT8 = 980 * MB;
constexpr size_t OFF_WSC = 983 * MB;
constexpr size_t OFF_MIX8 = OFF_MIX;
constexpr size_t OFF_SAM = OFF_MIX + 64 * MB;
constexpr size_t OFF_H8 = OFF_H;
constexpr size_t OFF_SAH = OFF_H + 64 * MB;
constexpr size_t WS_NEED = 984 * MB;
constexpr size_t SLICE = (size_t)NEXP * 128;

struct Params {
  const float* x; const float* norm1_g; const float* w_in; const float* ln_v_g; const float* ln_v_b;
  const float* w_spatial; const float* b_spatial; const float* out_norm_a_g; const float* out_norm_b_g;
  const float* w_out; const float* norm2_g; const float* w_query; const float* sub_keys;
  const float* expert_u; const float* expert_v; const float* final_norm_g;
  float* out; unsigned char* ws;
};

__device__ __forceinline__ unsigned cvtpk(float lo, float hi) { unsigned r; asm volatile("v_cvt_pk_bf16_f32 %0, %1, %2" : "=v"(r) : "v"(lo), "v"(hi)); return r; }
__device__ __forceinline__ float bf_lo(unsigned w) { return __uint_as_float(w << 16); }
__device__ __forceinline__ float bf_hi(unsigned w) { return __uint_as_float(w & 0xffff0000u); }
__device__ __forceinline__ float dot2(unsigned a, unsigned b, float acc) { return __builtin_amdgcn_fdot2_f32_bf16(__builtin_bit_cast(bf16x2v, a), __builtin_bit_cast(bf16x2v, b), acc, false); }
__device__ __forceinline__ float gelu_tanh(float x) {
  const float u = x * (1.5957691216057308f + 0.07135481627260026f * x * x);
  return x * __builtin_amdgcn_rcpf(1.0f + __expf(-u));
}
template <int CTRL> __device__ __forceinline__ float dppf(float x) { return __builtin_bit_cast(float, __builtin_amdgcn_mov_dpp(__builtin_bit_cast(int, x), CTRL, 0xf, 0xf, true)); }
__device__ __forceinline__ float sum8(float s) { s += dppf<0xB1>(s); s += dppf<0x4E>(s); s += dppf<0x141>(s); return s; }
__device__ __forceinline__ float max8(float s) { s = fmaxf(s, dppf<0xB1>(s)); s = fmaxf(s, dppf<0x4E>(s)); s = fmaxf(s, dppf<0x141>(s)); return s; }
__device__ __forceinline__ float sum_x16(float v) { const auto w = __builtin_amdgcn_permlane16_swap(__float_as_uint(v), __float_as_uint(v), false, false); return __uint_as_float(w[0]) + __uint_as_float(w[1]); }
__device__ __forceinline__ float sum_x32(float v) { const auto w = __builtin_amdgcn_permlane32_swap(__float_as_uint(v), __float_as_uint(v), false, false); return __uint_as_float(w[0]) + __uint_as_float(w[1]); }
__device__ __forceinline__ float max_x16(float v) { const auto w = __builtin_amdgcn_permlane16_swap(__float_as_uint(v), __float_as_uint(v), false, false); return fmaxf(__uint_as_float(w[0]), __uint_as_float(w[1])); }
__device__ __forceinline__ float max_x32(float v) { const auto w = __builtin_amdgcn_permlane32_swap(__float_as_uint(v), __float_as_uint(v), false, false); return fmaxf(__uint_as_float(w[0]), __uint_as_float(w[1])); }
__device__ __forceinline__ float sum16(float v) { v = sum8(v); return v + dppf<0x128>(v); }
__device__ __forceinline__ float max16(float v) { v = max8(v); return fmaxf(v, dppf<0x128>(v)); }
__device__ __forceinline__ float wave_sum(float v) { return sum_x32(sum_x16(sum16(v))); }
__device__ __forceinline__ float wave_max(float v) { return max_x32(max_x16(max16(v))); }
__device__ __forceinline__ int lane_id_opaque() { int l; asm volatile("v_mbcnt_lo_u32_b32 %0, -1, 0\n\tv_mbcnt_hi_u32_b32 %0, -1, %0" : "=v"(l)); return l; }
#define THREAD_IDS const int lane = lane_id_opaque(); const int wid = __builtin_amdgcn_readfirstlane((int)(threadIdx.x >> 6)); const int tid = wid * 64 + lane; (void)tid; (void)wid;
#define WAIT_V(n) asm volatile("s_waitcnt vmcnt(%0)" ::"n"(n) : "memory")
#define WAIT_L(n) asm volatile("s_waitcnt lgkmcnt(%0)" ::"n"(n) : "memory")

__device__ __forceinline__ void convert_expert_row(const Params& p, int r, int lane) {
  unsigned char* ws = p.ws;
  const int tab = r >= NEXP, e = r - tab * NEXP;
  const float* src = (tab ? p.expert_v : p.expert_u) + (size_t)e * DM + lane * 16;
  f32x4 v[4]; float am = 0.f;
#pragma unroll
  for (int i = 0; i < 4; ++i) { v[i] = __builtin_nontemporal_load((const f32x4*)(src + 4 * i)); am = fmaxf(am, fmaxf(fmaxf(fabsf(v[i][0]), fabsf(v[i][1])), fmaxf(fabsf(v[i][2]), fabsf(v[i][3])))); }
  if (tab) {
    am = wave_max(am);
    const float qs = am > 0.f ? 6.0f / am : 1.0f, dq = am > 0.f ? am * (1.0f / 6.0f) : 1.0f;
    u32x2 w = (u32x2){0u, 0u};
#pragma unroll
    for (int i = 0; i < 4; ++i)
#pragma unroll
      for (int j = 0; j < 4; ++j) {
        const float x = v[i][j] * qs, a = fabsf(x);
        const unsigned m = a < 0.25f ? 0u : a < 0.75f ? 1u : a < 1.25f ? 2u : a < 1.75f ? 3u : a < 2.5f ? 4u : a < 3.5f ? 5u : a < 5.0f ? 6u : 7u;
        const unsigned c = m | (x < 0.f ? 8u : 0u);
        w[i >> 1] |= c << (4 * (4 * (i & 1) + j));
      }
    *(u32x2*)(ws + OFF_EV + (size_t)(lane >> 4) * SLICE + (size_t)e * 128 + (lane & 15) * 8) = w;
    if (lane == 0) ((float*)(ws + OFF_SCL))[2 * e + 1] = dq;
  } else {
    am = 0.f;
    f32x4 vg[4];
#pragma unroll
    for (int i = 0; i < 4; ++i) { vg[i] = v[i] * *(const f32x4*)(p.norm2_g + lane * 16 + 4 * i); am = fmaxf(am, fmaxf(fmaxf(fabsf(vg[i][0]), fabsf(vg[i][1])), fmaxf(fabsf(vg[i][2]), fabsf(vg[i][3])))); }
    am = max16(am);
    const float qs = am > 0.f ? 8.0f / am : 0.f, dq = am * 0.125f;
    u32x2 w = (u32x2){0u, 0u};
#pragma unroll
    for (int i = 0; i < 4; ++i)
#pragma unroll
      for (int j = 0; j < 4; ++j) {
        const int n = (int)fminf(fmaxf(floorf(vg[i][j] * qs), -8.0f), 7.0f);
        w[i >> 1] |= ((unsigned)n & 15u) << (4 * ((i & 1) ? 2 * j + 1 : 2 * j));
      }
    *(u32x2*)(ws + OFF_EU + (size_t)(lane >> 4) * SLICE + (size_t)e * 128 + (lane & 15) * 8) = w;
    if ((lane & 15) == 0) ((float*)(ws + OFF_SCLU))[4 * e + (lane >> 4)] = dq;
  }
}

__device__ void phase_prep(const Params& p, unsigned char* smem) {
  THREAD_IDS
  unsigned char* ws = p.ws;
  {
    float* T = (float*)smem;
    constexpr int T_IN = 16 * 40, T_OUT = 16 * 16, T_Q = 16 * 32;
    for (int tile = blockIdx.x; tile < T_IN + T_OUT; tile += gridDim.x) {
      const float* src; bf16_t* dst; int N, tt;
      if (tile < T_IN) { src = p.w_in; dst = (bf16_t*)(ws + OFF_WIN); N = 2560; tt = tile; }
      else if (tile < T_IN + T_OUT) { src = p.w_out; dst = (bf16_t*)(ws + OFF_WOUT); N = 1024; tt = tile - T_IN; }
      else { src = p.w_query; dst = (bf16_t*)(ws + OFF_WQ); N = 2048; tt = tile - T_IN - T_OUT; }
      const int nt = N / 64, k0 = (tt / nt) * 64, n0 = (tt % nt) * 64;
#pragma unroll
      for (int i = 0; i < 2; ++i) {
        const int r = (tid >> 4) + 32 * i, c4 = (tid & 15) * 4;
        const f32x4 v = *(const f32x4*)(src + (size_t)(k0 + r) * N + n0 + c4);
        T[r * 65 + c4 + 0] = v[0]; T[r * 65 + c4 + 1] = v[1]; T[r * 65 + c4 + 2] = v[2]; T[r * 65 + c4 + 3] = v[3];
      }
      __syncthreads();
      {
        const int n = tid >> 3, k8 = (tid & 7) * 8;
        u32x4 w;
        float gk[8];
#pragma unroll
        for (int j = 0; j < 8; ++j) gk[j] = (tile >= T_IN + T_OUT) ? p.norm2_g[k0 + k8 + j] : 1.0f;
        w[0] = cvtpk(T[(k8 + 0) * 65 + n] * gk[0], T[(k8 + 1) * 65 + n] * gk[1]); w[1] = cvtpk(T[(k8 + 2) * 65 + n] * gk[2], T[(k8 + 3) * 65 + n] * gk[3]);
        w[2] = cvtpk(T[(k8 + 4) * 65 + n] * gk[4], T[(k8 + 5) * 65 + n] * gk[5]); w[3] = cvtpk(T[(k8 + 6) * 65 + n] * gk[6], T[(k8 + 7) * 65 + n] * gk[7]);
        int nr = n0 + n;
        if (tile < T_IN) {
          if (nr >= 1024 && nr < 2048) nr = (nr & ~48) | ((nr & 16) << 1) | ((nr & 32) >> 1);
          else { const int a = nr & 31; nr = (nr & ~31) | (((a >> 2) & 1) << 4) | ((a >> 3) << 2) | (a & 3); }
        }
        *(u32x4*)(dst + (size_t)nr * 1024 + k0 + k8) = w;
      }
      __syncthreads();
    }
  }
  {
    const size_t gt = (size_t)blockIdx.x * NTHREADS + tid, gn = (size_t)gridDim.x * NTHREADS;
    const float* srcs[1] = {p.w_spatial};
    const size_t offs[1] = {OFF_WSP};
    const size_t cnts[1] = {8 * 128 * 128 / 8};
#pragma unroll
    for (int a = 0; a < 1; ++a) {
      const float* s = srcs[a]; bf16_t* d = (bf16_t*)(ws + offs[a]);
      for (size_t i = gt; i < cnts[a]; i += gn) {
        const f32x4 v0 = *(const f32x4*)(s + i * 8), v1 = *(const f32x4*)(s + i * 8 + 4);
        u32x4 w; w[0] = cvtpk(v0[0], v0[1]); w[1] = cvtpk(v0[2], v0[3]); w[2] = cvtpk(v1[0], v1[1]); w[3] = cvtpk(v1[2], v1[3]);
        *(u32x4*)(d + i * 8) = w;
      }
    }
    f32x2* RT = (f32x2*)(ws + OFF_RT);
    for (size_t i = gt; i < (size_t)SEQ * 32; i += gn) {
      const int pos = (int)(i >> 5), j = (int)(i & 31);
      const double inv = pow(10000.0, -(double)j / 32.0), ang = (double)pos * inv;
      f32x2 cs; cs[0] = (float)cos(ang); cs[1] = (float)sin(ang);
      RT[i] = cs;
    }
  }
  {
    bf16_t* WQ = (bf16_t*)(ws + OFF_WQ);
    const int fr = lane & 15, fq = lane >> 4;
    for (int tile = blockIdx.x * 8 + wid; tile < 16 * 8 * 64; tile += gridDim.x * 8) {
      const int hp = tile >> 9, kt = (tile >> 6) & 7, dt = tile & 63, pp = hp & 1;
      f32x4 acc = (f32x4){0.f, 0.f, 0.f, 0.f};
#pragma unroll
      for (int ks = 0; ks < 4; ++ks) {
        const float* ap = p.w_query + (size_t)(dt * 16 + fr) * 2048 + hp * 128 + ks * 32 + fq * 8;
        const float* bp = p.sub_keys + ((size_t)pp * 128 + kt * 16 + fr) * 128 + ks * 32 + fq * 8;
        const f32x4 a0 = *(const f32x4*)ap, a1 = *(const f32x4*)(ap + 4), b0 = *(const f32x4*)bp, b1 = *(const f32x4*)(bp + 4);
        u32x4 aw, bw;
        aw[0] = cvtpk(a0[0], a0[1]); aw[1] = cvtpk(a0[2], a0[3]); aw[2] = cvtpk(a1[0], a1[1]); aw[3] = cvtpk(a1[2], a1[3]);
        bw[0] = cvtpk(b0[0], b0[1]); bw[1] = cvtpk(b0[2], b0[3]); bw[2] = cvtpk(b1[0], b1[1]); bw[3] = cvtpk(b1[2], b1[3]);
        acc = __builtin_amdgcn_mfma_f32_16x16x32_bf16(__builtin_bit_cast(bf16x8, aw), __builtin_bit_cast(bf16x8, bw), acc, 0, 0, 0);
      }
      const f32x4 g2 = *(const f32x4*)(p.norm2_g + dt * 16 + 4 * fq);
      u32x2 w; w[0] = cvtpk(acc[0] * g2[0], acc[1] * g2[1]); w[1] = cvtpk(acc[2] * g2[2], acc[3] * g2[3]);
      *(u32x2*)(WQ + (size_t)(hp * 128 + kt * 16 + fr) * 1024 + dt * 16 + 4 * fq) = w;
    }
  }
  {
    float* SS = (float*)(ws + OFF_SS);
    for (int i = blockIdx.x * NTHREADS + tid; i < NTOK; i += gridDim.x * NTHREADS) SS[i] = 0.f;
    if (blockIdx.x == 0 && tid < 16 * 32) { ((unsigned*)(ws + OFF_Q))[tid] = 0u; ((unsigned*)(ws + OFF_Q))[512 + tid] = 0u; }
  }
  {
    f32x4 g[4];
#pragma unroll
    for (int i = 0; i < 4; ++i) g[i] = *(const f32x4*)(p.norm1_g + (i >> 1) * 512 + lane * 8 + (i & 1) * 4);
    const int rstep = gridDim.x * 8;
    f32x4 vn[4];
    { const int r0 = blockIdx.x * 8 + wid;
#pragma unroll
      for (int i = 0; i < 4; ++i) vn[i] = __builtin_nontemporal_load((const f32x4*)(p.x + (size_t)r0 * DM + (i >> 1) * 512 + lane * 8 + (i & 1) * 4)); }
    for (int row = blockIdx.x * 8 + wid; row < NTOK; row += rstep) {
      f32x4 v[4]; float ss = 0.f;
#pragma unroll
      for (int i = 0; i < 4; ++i) { v[i] = vn[i]; ss += v[i][0] * v[i][0] + v[i][1] * v[i][1] + v[i][2] * v[i][2] + v[i][3] * v[i][3]; }
      if (row + rstep < NTOK) {
#pragma unroll
        for (int i = 0; i < 4; ++i) vn[i] = __builtin_nontemporal_load((const f32x4*)(p.x + (size_t)(row + rstep) * DM + (i >> 1) * 512 + lane * 8 + (i & 1) * 4));
      }
      ss = wave_sum(ss);
      const float rs = rsqrtf(ss * (1.0f / DM) + EPS);
      float am = 0.f;
#pragma unroll
      for (int i = 0; i < 4; ++i) { v[i] = v[i] * g[i] * rs; am = fmaxf(am, fmaxf(fmaxf(fabsf(v[i][0]), fabsf(v[i][1])), fmaxf(fabsf(v[i][2]), fabsf(v[i][3])))); }
      am = wave_max(am);
      const float qs = am > 0.f ? 127.0f / am : 0.f;
#pragma unroll
      for (int hf = 0; hf < 2; ++hf) {
        u32x2 q;
#pragma unroll
        for (int e = 0; e < 2; ++e) {
          const f32x4 a = v[2 * hf + e] * qs;
          q[e] = ((unsigned)__float2int_rn(a[0]) & 0xffu) | (((unsigned)__float2int_rn(a[1]) & 0xffu) << 8) | (((unsigned)__float2int_rn(a[2]) & 0xffu) << 16) | ((unsigned)__float2int_rn(a[3]) << 24);
        }
        *(u32x2*)(ws + OFF_H8 + (size_t)row * DM + hf * 512 + lane * 8) = q;
      }
      if (lane == 0) ((float*)(ws + OFF_SAH))[row] = am * (1.0f / 127.0f);
    }
  }
}

constexpr int HTB = 128 * 64 * 2;
__device__ __forceinline__ int lds_byte(int r, int c) { const int st = (r >> 4) * 2 + (c >> 5), ob = (r & 15) * 64 + (c & 31) * 2; return st * 1024 + (ob ^ (((ob >> 9) & 1) << 5)); }
__device__ __forceinline__ void stage_rc(int b, int& R, int& C) { const int st = b >> 10, sb = b & 1023, swz = sb ^ (((sb >> 9) & 1) << 5); R = (st >> 1) * 16 + swz / 64; C = (st & 1) * 32 + (swz % 64) / 2; }
struct Unit { int pm, pn; };
struct StaticOrder {
  int nM, nN, nwg, G, c;
  __device__ void init(int M, int N, int G_, int c_) { nM = M / 256; nN = N / 256; nwg = nM * nN; G = G_; c = c_; }
  __device__ bool next(int i, Unit& u) const {
    const long L = (long)i * G + c; if (L >= nwg) return false;
    int wgid = (int)L; { const int q = nwg / 8, r = nwg % 8, xcd = wgid % 8, off = wgid / 8; wgid = (xcd < r ? xcd * (q + 1) : r * (q + 1) + (xcd - r) * q) + off; }
    const int nig = 8 * nN, gid = wgid / nig, fm = gid * 8, gsz = (nM - fm) < 8 ? (nM - fm) : 8;
    u.pm = fm + ((wgid % nig) % gsz); u.pn = (wgid % nig) / gsz; return true;
  }
};
struct OneUnit { Unit u; __device__ bool next(int i, Unit& o) const { if (i) return false; o = u; return true; } };

template <class Epi, class Sched, bool I8 = false>
__device__ __forceinline__ void gemm_phase(unsigned char* smem, const bf16_t* Ag, const bf16_t* Btg, const int K, const Sched& S, const Epi& E, const float* SA = nullptr, const float* SB = nullptr) {
  THREAD_IDS const int wr = wid >> 2, wc = wid & 3, fr = lane & 15, fq = lane >> 4;
  __attribute__((address_space(3))) unsigned char* lds = (__attribute__((address_space(3))) unsigned char*)smem;
  const int nt = K / 64;
  unsigned voff[2];
#pragma unroll
  for (int i = 0; i < 2; ++i) { int R, C; stage_rc(tid * 16 + i * 8192, R, C); voff[i] = (unsigned)(R * K + C) * 2u; }
  const size_t kstep = 128, hstep = (size_t)128 * K * 2, tstep = 2 * hstep;
  const unsigned ldsw = (unsigned)wid * 1024u;
  const int aoff = lds_byte(wr * 64 + fr, fq * 8), boff = lds_byte(wc * 32 + fr, fq * 8);
#define PG8_SA(b, h) (((b) * 2 + (h)) * HTB)
#define PG8_SB(b, h) ((4 + (b) * 2 + (h)) * HTB)
#define PG8_STAGE(bufoff, gbase) do { _Pragma("unroll") for (int _i = 0; _i < 2; ++_i) \
    __builtin_amdgcn_global_load_lds((const unsigned*)((const char*)(gbase) + voff[_i]), (__attribute__((address_space(3))) unsigned*)(lds + (bufoff) + ldsw + _i * 8192), 16, 0, 0); } while (0)
#define PG8_LDA(dst, b, h) do { _Pragma("unroll") for (int m = 0; m < 4; ++m) _Pragma("unroll") for (int k = 0; k < 2; ++k) dst[m][k] = *(const __attribute__((address_space(3))) bf16x8*)(lds + PG8_SA(b, h) + aoff + m * 2048 + k * 1024); } while (0)
#define PG8_LDB(dst, b, h) do { _Pragma("unroll") for (int n = 0; n < 2; ++n) _Pragma("unroll") for (int k = 0; k < 2; ++k) dst[n][k] = *(const __attribute__((address_space(3))) bf16x8*)(lds + PG8_SB(b, h) + boff + n * 2048 + k * 1024); } while (0)
#define PG8_MMA(ai, bj, At, Bt) do { __builtin_amdgcn_s_setprio(1); _Pragma("unroll") for (int m = 0; m < 4; ++m) _Pragma("unroll") for (int n = 0; n < 2; ++n) _Pragma("unroll") for (int k = 0; k < 2; ++k) \
    { if constexpr (I8) acc[ai][bj][m][n] = __builtin_bit_cast(f32x4, __builtin_amdgcn_mfma_i32_16x16x64_i8(__builtin_bit_cast(i32x4v, Bt[n][k]), __builtin_bit_cast(i32x4v, At[m][k]), __builtin_bit_cast(i32x4v, acc[ai][bj][m][n]), 0, 0, 0)); \
      else acc[ai][bj][m][n] = __builtin_amdgcn_mfma_f32_16x16x32_bf16(Bt[n][k], At[m][k], acc[ai][bj][m][n], 0, 0, 0); } __builtin_amdgcn_s_setprio(0); } while (0)
#define PG8_WAIT_V(n) asm volatile("s_waitcnt vmcnt(" #n ")" ::: "memory")
#define PG8_WAIT_L(n) asm volatile("s_waitcnt lgkmcnt(" #n ")" ::: "memory")
#define PG8_BAR __builtin_amdgcn_s_barrier()
#define PG8_SCHED __builtin_amdgcn_sched_barrier(0)
  Unit cur, nxt; int ui = 0;
  if (!S.next(0, cur)) return;
  f32x4 acc[2][2][4][2];
#pragma unroll
  for (int a = 0; a < 2; ++a)
#pragma unroll
    for (int b = 0; b < 2; ++b)
#pragma unroll
      for (int m = 0; m < 4; ++m)
#pragma unroll
        for (int n = 0; n < 2; ++n) acc[a][b][m][n] = (f32x4){0.f, 0.f, 0.f, 0.f};
  bf16x8 At[4][2], B0[2][2], B1[2][2];
  const char* cA = (const char*)Ag + (size_t)cur.pm * tstep; const char* cB = (const char*)Btg + (size_t)cur.pn * tstep;
  auto rescale = [&]() {
    float sa[2][4]; f32x4 sb[2][2];
#pragma unroll
    for (int a = 0; a < 2; ++a)
#pragma unroll
      for (int m = 0; m < 4; ++m) sa[a][m] = SA[cur.pm * 256 + a * 128 + wr * 64 + m * 16 + fr];
#pragma unroll
    for (int b = 0; b < 2; ++b)
#pragma unroll
      for (int n = 0; n < 2; ++n) sb[b][n] = *(const f32x4*)(SB + cur.pn * 256 + b * 128 + wc * 32 + n * 16 + 4 * fq);
#pragma unroll
    for (int a = 0; a < 2; ++a)
#pragma unroll
      for (int b = 0; b < 2; ++b)
#pragma unroll
        for (int m = 0; m < 4; ++m)
#pragma unroll
          for (int n = 0; n < 2; ++n) {
            const i32x4v iv = __builtin_bit_cast(i32x4v, acc[a][b][m][n]);
            acc[a][b][m][n] = (f32x4){(float)iv[0], (float)iv[1], (float)iv[2], (float)iv[3]} * sb[b][n] * sa[a][m];
          }
  };
  PG8_STAGE(PG8_SB(0, 0), cB); PG8_STAGE(PG8_SA(0, 0), cA); PG8_STAGE(PG8_SB(0, 1), cB + hstep); PG8_STAGE(PG8_SA(0, 1), cA + hstep);
  if (wr == 1) PG8_BAR;
  PG8_WAIT_V(4); PG8_BAR;
  PG8_STAGE(PG8_SB(1, 0), cB + kstep); PG8_STAGE(PG8_SA(1, 0), cA + kstep); PG8_STAGE(PG8_SB(1, 1), cB + hstep + kstep);
  PG8_WAIT_V(6); PG8_BAR;
  for (;;) {
    const bool has_next = S.next(ui + 1, nxt);
    const char* nA = has_next ? (const char*)Ag + (size_t)nxt.pm * tstep : cA; const char* nB = has_next ? (const char*)Btg + (size_t)nxt.pn * tstep : cB;
    for (int t = 0; t < nt; t += 2) {
      const bool last = (t == nt - 2);
      const char* a1 = cA + (size_t)(t + 1) * kstep;
      const char* a2 = last ? nA : cA + (size_t)(t + 2) * kstep; const char* b2 = last ? nB : cB + (size_t)(t + 2) * kstep;
      const char* a3 = a2 + kstep; const char* b3 = b2 + kstep;
      PG8_LDB(B0, 0, 0); PG8_SCHED; PG8_LDA(At, 0, 0); PG8_STAGE(PG8_SA(1, 1), a1 + hstep);
      PG8_WAIT_L(8); PG8_BAR; PG8_WAIT_L(0); PG8_MMA(0, 0, At, B0); PG8_BAR; PG8_SCHED;
      PG8_LDB(B1, 0, 1); PG8_STAGE(PG8_SB(0, 0), b2);
      PG8_BAR; PG8_WAIT_L(0); PG8_MMA(0, 1, At, B1); PG8_BAR;
      PG8_LDA(At, 0, 1); PG8_STAGE(PG8_SA(0, 0), a2);
      PG8_BAR; PG8_WAIT_L(0); PG8_MMA(1, 0, At, B0); PG8_BAR; PG8_SCHED;
      PG8_STAGE(PG8_SB(0, 1), b2 + hstep);
      PG8_WAIT_V(6); PG8_BAR; PG8_MMA(1, 1, At, B1); PG8_BAR;
      PG8_LDB(B0, 1, 0); PG8_SCHED; PG8_LDA(At, 1, 0); PG8_STAGE(PG8_SA(0, 1), a2 + hstep);
      PG8_WAIT_L(8); PG8_BAR; PG8_WAIT_L(0); PG8_MMA(0, 0, At, B0); PG8_BAR; PG8_SCHED;
      PG8_LDB(B1, 1, 1); PG8_STAGE(PG8_SB(1, 0), b3);
      PG8_BAR; PG8_WAIT_L(0); PG8_MMA(0, 1, At, B1); PG8_BAR;
      PG8_LDA(At, 1, 1); PG8_STAGE(PG8_SA(1, 0), a3);
      PG8_BAR; PG8_WAIT_L(0); PG8_MMA(1, 0, At, B0); PG8_BAR; PG8_SCHED;
      PG8_STAGE(PG8_SB(1, 1), b3 + hstep);
      PG8_WAIT_V(6); PG8_BAR; PG8_MMA(1, 1, At, B1); PG8_BAR;
    }
    if constexpr (!Epi::AFTER_DRAIN) E(acc, cur, wr, wc, fr, fq);
    if (!has_next) break;
#pragma unroll
    for (int a = 0; a < 2; ++a)
#pragma unroll
      for (int b = 0; b < 2; ++b)
#pragma unroll
        for (int m = 0; m < 4; ++m)
#pragma unroll
          for (int n = 0; n < 2; ++n) acc[a][b][m][n] = (f32x4){0.f, 0.f, 0.f, 0.f};
    cur = nxt; cA = nA; cB = nB; ++ui;
  }
  PG8_WAIT_V(0);
  if (wr == 0) PG8_BAR;
  PG8_BAR;
  if constexpr (Epi::AFTER_DRAIN) { if constexpr (I8) rescale(); E.fused(acc, cur, wr, wc, fr, fq, smem, wid, lane); }
#undef PG8_SA
#undef PG8_SB
#undef PG8_STAGE
#undef PG8_LDA
#undef PG8_LDB
#undef PG8_MMA
#undef PG8_WAIT_V
#undef PG8_WAIT_L
#undef PG8_BAR
#undef PG8_SCHED
}

struct EpiIn {
  static constexpr bool AFTER_DRAIN = false;
  bf16_t* P; const f32x2* RT; const float* SA; const float* SB;
  __device__ __forceinline__ void operator()(f32x4 (&acc)[2][2][4][2], const Unit& u, int wr, int wc, int fr, int fq) const {
    const int kind = u.pn >> 1;
    float sa[2][4]; f32x4 sb[2][2];
#pragma unroll
    for (int ai = 0; ai < 2; ++ai)
#pragma unroll
      for (int m = 0; m < 4; ++m) sa[ai][m] = SA[u.pm * 256 + ai * 128 + wr * 64 + m * 16 + fr];
#pragma unroll
    for (int bj = 0; bj < 2; ++bj)
#pragma unroll
      for (int n = 0; n < 2; ++n) sb[bj][n] = *(const f32x4*)(SB + u.pn * 256 + bj * 128 + wc * 32 + n * 16 + 4 * fq);
    const bool rot = (kind == 2 || kind == 3);
    f32x4 rtn[2];
    auto ld_rt = [&](int ai, int m) {
      const int pos = (u.pm * 256 + ai * 128 + wr * 64 + m * 16 + fr) & (SEQ - 1);
      const f32x4* rt = (const f32x4*)(RT + pos * 32 + 16 * (wc & 1) + 4 * fq);
      rtn[0] = rt[0]; rtn[1] = rt[1];
    };
    if (rot) ld_rt(0, 0);
#pragma unroll
    for (int ai = 0; ai < 2; ++ai)
#pragma unroll
      for (int m = 0; m < 4; ++m) {
        const int row = u.pm * 256 + ai * 128 + wr * 64 + m * 16 + fr;
        const f32x4 c01 = rtn[0], c23 = rtn[1];
        if (rot && (ai * 4 + m + 1 < 8)) ld_rt((ai * 4 + m + 1) >> 2, (ai * 4 + m + 1) & 3);
#pragma unroll
        for (int bj = 0; bj < 2; ++bj)
#pragma unroll
          for (int n = 0; n < 2; ++n) {
            const i32x4v iv = __builtin_bit_cast(i32x4v, acc[ai][bj][m][n]);
            acc[ai][bj][m][n] = (f32x4){(float)iv[0], (float)iv[1], (float)iv[2], (float)iv[3]} * sb[bj][n] * sa[ai][m];
          }
        if (kind <= 1) {
#pragma unroll
          for (int bj = 0; bj < 2; ++bj) {
            f32x4 v0 = acc[ai][bj][m][0], v1 = acc[ai][bj][m][1];
#pragma unroll
            for (int r = 0; r < 4; ++r) { v0[r] = gelu_tanh(v0[r]); v1[r] = gelu_tanh(v1[r]); }
            u32x4 w; w[0] = cvtpk(v0[0], v0[1]); w[1] = cvtpk(v0[2], v0[3]); w[2] = cvtpk(v1[0], v1[1]); w[3] = cvtpk(v1[2], v1[3]);
            *(u32x4*)(P + (size_t)row * DIN + u.pn * 256 + bj * 128 + wc * 32 + 8 * fq) = w;
          }
        } else if (kind <= 3) {
          const int j0 = 16 * (wc & 1) + 4 * fq;
          const float sc = (kind == 2) ? 0.18033688011112042f : 1.0f;
          const float cs[4] = {c01[0], c01[2], c23[0], c23[2]}, sn[4] = {c01[1], c01[3], c23[1], c23[3]};
#pragma unroll
          for (int bj = 0; bj < 2; ++bj) {
            f32x4 o1, o2;
#pragma unroll
            for (int r = 0; r < 4; ++r) {
              const float t1 = acc[ai][bj][m][0][r], t2 = acc[ai][bj][m][1][r];
              o1[r] = (t1 * cs[r] - t2 * sn[r]) * sc; o2[r] = (t2 * cs[r] + t1 * sn[r]) * sc;
            }
            bf16_t* dst = P + (size_t)row * DIN + u.pn * 256 + bj * 128 + (wc >> 1) * 64 + j0;
            u32x2 w; w[0] = cvtpk(o1[0], o1[1]); w[1] = cvtpk(o1[2], o1[3]); *(u32x2*)dst = w;
            w[0] = cvtpk(o2[0], o2[1]); w[1] = cvtpk(o2[2], o2[3]); *(u32x2*)(dst + 32) = w;
          }
        } else {
#pragma unroll
          for (int bj = 0; bj < 2; ++bj) {
            const f32x4 v0 = acc[ai][bj][m][0], v1 = acc[ai][bj][m][1];
            u32x4 w; w[0] = cvtpk(v0[0], v0[1]); w[1] = cvtpk(v0[2], v0[3]); w[2] = cvtpk(v1[0], v1[1]); w[3] = cvtpk(v1[2], v1[3]);
            *(u32x4*)(P + (size_t)row * DIN + u.pn * 256 + bj * 128 + wc * 32 + 8 * fq) = w;
          }
        }
      }
  }
};

struct EpiOut {
  static constexpr bool AFTER_DRAIN = false;
  const float* x; bf16_t* x1; const float* SA; const float* SB;
  __device__ __forceinline__ void operator()(f32x4 (&acc)[2][2][4][2], const Unit& u, int wr, int wc, int fr, int fq) const {
    f32x4 sbv[2][2];
#pragma unroll
    for (int bj = 0; bj < 2; ++bj)
#pragma unroll
      for (int n = 0; n < 2; ++n) sbv[bj][n] = *(const f32x4*)(SB + u.pn * 256 + bj * 128 + wc * 32 + n * 16 + 4 * fq);
#pragma unroll
    for (int ai = 0; ai < 2; ++ai) {
      f32x4 xv[4][2][2]; float sav[4];
#pragma unroll
      for (int m = 0; m < 4; ++m) sav[m] = SA[u.pm * 256 + ai * 128 + wr * 64 + m * 16 + fr];
#pragma unroll
      for (int m = 0; m < 4; ++m) {
        const size_t o = (size_t)(u.pm * 256 + ai * 128 + wr * 64 + m * 16 + fr) * DM + u.pn * 256 + wc * 32 + 4 * fq;
#pragma unroll
        for (int bj = 0; bj < 2; ++bj)
#pragma unroll
          for (int n = 0; n < 2; ++n) xv[m][bj][n] = __builtin_nontemporal_load((const f32x4*)(x + o + bj * 128 + n * 16));
      }
#pragma unroll
      for (int m = 0; m < 4; ++m) {
        const size_t o = (size_t)(u.pm * 256 + ai * 128 + wr * 64 + m * 16 + fr) * DM + u.pn * 256 + wc * 32 + 4 * fq;
#pragma unroll
        for (int bj = 0; bj < 2; ++bj)
#pragma unroll
          for (int n = 0; n < 2; ++n) {
            const i32x4v iv = __builtin_bit_cast(i32x4v, acc[ai][bj][m][n]);
            const f32x4 v = xv[m][bj][n] + (f32x4){(float)iv[0], (float)iv[1], (float)iv[2], (float)iv[3]} * sbv[bj][n] * sav[m]; u32x2 w; w[0] = cvtpk(v[0], v[1]); w[1] = cvtpk(v[2], v[3]); *(u32x2*)(x1 + o + bj * 128 + n * 16) = w; }
      }
    }
  }
};

__device__ __forceinline__ void top16_insert(float (&t)[16], float x) {
#pragma unroll
  for (int s = 15; s >= 1; --s) t[s] = __builtin_amdgcn_fmed3f(t[s - 1], t[s], x);
  t[0] = fmaxf(t[0], x);
}
struct EpiSel {
  static constexpr bool AFTER_DRAIN = true;
  unsigned short* SELE; float* SELG; const float* RS; const Params* prm; int useq;
  __device__ __forceinline__ void select_half(const float* Srow, float (&t)[16]) const {
#pragma unroll
    for (int s = 0; s < 16; ++s) t[s] = -__builtin_inff();
#pragma unroll 4
    for (int k4 = 0; k4 < 32; ++k4) {
      const f32x4 v = *(const f32x4*)(Srow + k4 * 4);
#pragma unroll
      for (int j = 0; j < 4; ++j) top16_insert(t, __uint_as_float((__float_as_uint(v[j]) & 0xffffff80u) | (unsigned)(k4 * 4 + j)));
    }
  }
  __device__ __forceinline__ void fused(f32x4 (&acc)[2][2][4][2], const Unit& u, int wr, int wc, int fr, int fq, unsigned char* smem, int wid, int lane) const {
    const int tid = wid * 64 + lane;
    float rsv[2][4];
#pragma unroll
    for (int ai = 0; ai < 2; ++ai)
#pragma unroll
      for (int m = 0; m < 4; ++m) rsv[ai][m] = RS[u.pm * 256 + ai * 128 + wr * 64 + m * 16 + fr];
    float* S = (float*)smem;
    float t1[16], t2[16];
#pragma unroll
    for (int p2 = 0; p2 < 2; ++p2) {
#pragma unroll
      for (int ai = 0; ai < 2; ++ai)
#pragma unroll
        for (int m = 0; m < 4; ++m)
#pragma unroll
          for (int n = 0; n < 2; ++n) *(f32x4*)(S + (ai * 128 + wr * 64 + m * 16 + fr) * 132 + wc * 32 + n * 16 + 4 * fq) = acc[ai][p2][m][n] * rsv[ai][m];
      __syncthreads();
      if (tid < 256) { if (p2 == 0) select_half(S + tid * 132, t1); else select_half(S + tid * 132, t2); }
      else {
#pragma unroll 1
        for (int j = 0; j < 2; ++j) convert_expert_row(*prm, useq * 16 + (wid - 4) * 4 + p2 * 2 + j, lane);
      }
      __syncthreads();
    }
    if (tid < 256) {
      unsigned char* IX = smem + 135168 + tid * 32;
#pragma unroll
      for (int s = 0; s < 16; ++s) { IX[s] = (unsigned char)(__float_as_uint(t1[s]) & 0x7f); IX[16 + s] = (unsigned char)(__float_as_uint(t2[s]) & 0x7f); }
      float c[16];
#pragma unroll
      for (int s = 0; s < 16; ++s) c[s] = -__builtin_inff();
#pragma unroll
      for (int i = 0; i < 16; ++i)
#pragma unroll
        for (int j = 0; j < 16; ++j)
          if ((i + 1) * (j + 1) <= 16) {
            const float a = __uint_as_float(__float_as_uint(t1[i]) & 0xffffff80u), b = __uint_as_float(__float_as_uint(t2[j]) & 0xffffff80u);
            top16_insert(c, __uint_as_float((__float_as_uint(a + b) & 0xffffff00u) | (unsigned)(i * 16 + j)));
          }
      float g[16]; float gs = 0.f; int e[16];
      const float cmax = __uint_as_float(__float_as_uint(c[0]) & 0xffffff00u);
#pragma unroll
      for (int s = 0; s < 16; ++s) {
        const unsigned cb = __float_as_uint(c[s]); const int id = (int)(cb & 0xff);
        g[s] = __expf(__uint_as_float(cb & 0xffffff00u) - cmax); gs += g[s];
        e[s] = (int)IX[id >> 4] * 128 + (int)IX[16 + (id & 15)];
      }
      const float inv = 1.0f / gs;
      const size_t o = ((size_t)(u.pm * 256 + tid) * 8 + u.pn) * 16;
#pragma unroll
      for (int s4 = 0; s4 < 4; ++s4) {
        *(f32x4*)(SELG + o + s4 * 4) = (f32x4){g[s4 * 4] * inv, g[s4 * 4 + 1] * inv, g[s4 * 4 + 2] * inv, g[s4 * 4 + 3] * inv};
        *(u32x2*)(SELE + o + s4 * 4) = (u32x2){(unsigned)e[s4 * 4] | ((unsigned)e[s4 * 4 + 1] << 16), (unsigned)e[s4 * 4 + 2] | ((unsigned)e[s4 * 4 + 3] << 16)};
      }
    }
    __syncthreads();
  }
};

__device__ __forceinline__ void tr_read2(unsigned a0, unsigned a1, s16x4& r0, s16x4& r1) {
  asm volatile("ds_read_b64_tr_b16 %0, %2\n\tds_read_b64_tr_b16 %1, %3\n\ts_waitcnt lgkmcnt(0)" : "=&v"(r0), "=&v"(r1) : "v"(a0), "v"(a1) : "memory");
}
__device__ __forceinline__ void tr_read8(unsigned a0, unsigned a1, s16x4 (&r)[8]) {
  asm volatile("ds_read_b64_tr_b16 %0, %8\n\tds_read_b64_tr_b16 %1, %9\n\tds_read_b64_tr_b16 %2, %8 offset:32\n\tds_read_b64_tr_b16 %3, %9 offset:32\n\t"
               "ds_read_b64_tr_b16 %4, %8 offset:64\n\tds_read_b64_tr_b16 %5, %9 offset:64\n\tds_read_b64_tr_b16 %6, %8 offset:96\n\tds_read_b64_tr_b16 %7, %9 offset:96\n\ts_waitcnt lgkmcnt(0)"
               : "=&v"(r[0]), "=&v"(r[1]), "=&v"(r[2]), "=&v"(r[3]), "=&v"(r[4]), "=&v"(r[5]), "=&v"(r[6]), "=&v"(r[7]) : "v"(a0), "v"(a1) : "memory");
}
constexpr size_t OFF_OP01 = OFF_H;
constexpr size_t OFF_OP2 = OFF_XN;
constexpr size_t OFF_LSE = OFF_XN + 64 * MB;
__device__ void attn_phase(const Params& p, unsigned char* smem) {
  THREAD_IDS const int fr = lane & 15, fq = lane >> 4;
  const bf16_t* P = (const bf16_t*)(p.ws + OFF_P);
  float* LSE = (float*)(p.ws + OFF_LSE);
  unsigned char* Ks = smem; unsigned char* Vs = smem + 36864;
  const unsigned vbase = (unsigned)(uintptr_t)(__attribute__((address_space(3))) unsigned char*)Vs;
  constexpr int NITEM = 32 * 8 * 3 * 16;
  u32x4 kst[4], vst[4];
  bf16x8 qn0, qn1, qc0, qc1;
  auto stage_load = [&](int item) {
    const int ii = item & 15, br = (item >> 4) % 3, bh = item / 48, b = bh >> 3, h = bh & 7;
    const int d = br == 0 ? 16 : (br == 1 ? 4 : 1), Lb = 2048 / d;
    const int r = br == 0 ? ii : (br == 1 ? (ii & 3) : 0), qb = br == 0 ? 0 : (br == 1 ? (ii >> 2) : ii);
    const int kbase = 128 * qb - 64;
#pragma unroll
    for (int i = 0; i < 4; ++i) {
      const int c = tid + 512 * i, j = c >> 3, part = c & 7;
      int kp = kbase + j; kp = kp < 0 ? 0 : (kp > Lb - 1 ? Lb - 1 : kp);
      const bf16_t* src = P + ((size_t)b * SEQ + r + d * kp) * DIN + h * 64 + part * 8;
      kst[i] = *(const u32x4*)(src + 1536); vst[i] = *(const u32x4*)(src + 2048);
    }
    const size_t tokq = (size_t)b * SEQ + r + d * (128 * qb + 16 * wid + fr);
    qn0 = *(const bf16x8*)(P + tokq * DIN + 1024 + h * 64 + 8 * fq); qn1 = *(const bf16x8*)(P + tokq * DIN + 1024 + h * 64 + 32 + 8 * fq);
  };
  auto stage_write = [&]() {
#pragma unroll
    for (int i = 0; i < 4; ++i) {
      const int c = tid + 512 * i, j = c >> 3, part = c & 7;
      *(u32x4*)(Ks + j * 144 + part * 16) = kst[i]; *(u32x4*)(Vs + j * 160 + part * 16) = vst[i];
    }
  };
  int item = blockIdx.x;
  __syncthreads();
  if (item < NITEM) { stage_load(item); stage_write(); }
  qc0 = qn0; qc1 = qn1;
  __syncthreads();
  for (; item < NITEM; item += gridDim.x) {
    const int nxt = item + gridDim.x;
    if (nxt < NITEM) stage_load(nxt);
    {
      const int ii = item & 15, br = (item >> 4) % 3, bh = item / 48, b = bh >> 3, h = bh & 7;
      const int d = br == 0 ? 16 : (br == 1 ? 4 : 1), Lb = 2048 / d;
      const int r = br == 0 ? ii : (br == 1 ? (ii & 3) : 0), qb = br == 0 ? 0 : (br == 1 ? (ii >> 2) : ii);
      const int qpos = 128 * qb + 16 * wid + fr;
      const size_t tokq = (size_t)b * SEQ + r + d * qpos;
      const bf16x8 qf0 = qc0, qf1 = qc1;
      const int kt0 = 8 * qb - 4 + wid;
      f32x4 S[10];
#pragma unroll
      for (int T = 0; T < 10; ++T) {
        const bool live = (T < 9) && (kt0 + T >= 0) && (16 * (kt0 + T) < Lb);
        if (live) {
          const int ti = (wid + T) < 15 ? (wid + T) : 15;
          const unsigned char* kr = Ks + (16 * ti + fr) * 144 + fq * 16;
          const bf16x8 k0 = *(const bf16x8*)kr, k1 = *(const bf16x8*)(kr + 64);
          S[T] = __builtin_amdgcn_mfma_f32_16x16x32_bf16(k0, qf0, (f32x4){0.f, 0.f, 0.f, 0.f}, 0, 0, 0);
          S[T] = __builtin_amdgcn_mfma_f32_16x16x32_bf16(k1, qf1, S[T], 0, 0, 0);
        } else S[T] = (f32x4){-1e30f, -1e30f, -1e30f, -1e30f};
      }
      float mx = -1e30f;
#pragma unroll
      for (int rg = 0; rg < 4; ++rg) {
        S[0][rg] = (4 * fq + rg - fr >= 0) ? S[0][rg] : -1e30f;
        S[8][rg] = (4 * fq + rg - fr <= 0) ? S[8][rg] : -1e30f;
      }
#pragma unroll
      for (int T = 0; T < 9; ++T)
#pragma unroll
        for (int rg = 0; rg < 4; ++rg) mx = fmaxf(mx, S[T][rg]);
      mx = max_x32(max_x16(mx));
      float l = 0.f;
#pragma unroll
      for (int T = 0; T < 10; ++T)
#pragma unroll
        for (int rg = 0; rg < 4; ++rg) { S[T][rg] = __builtin_amdgcn_exp2f(S[T][rg] - mx); l += S[T][rg]; }
      l = sum_x32(sum_x16(l));
      f32x4 O[4];
#pragma unroll
      for (int dt = 0; dt < 4; ++dt) O[dt] = (f32x4){0.f, 0.f, 0.f, 0.f};
#pragma unroll
      for (int pr = 0; pr < 5; ++pr) {
        const int T0 = 2 * pr, T1 = 2 * pr + 1;
        const bool live0 = (kt0 + T0 >= 0) && (16 * (kt0 + T0) < Lb), live1 = (T1 < 9) && (kt0 + T1 >= 0) && (16 * (kt0 + T1) < Lb);
        if (!(live0 || live1)) continue;
        const int t0i = (wid + T0) < 15 ? (wid + T0) : 15, t1i = (wid + T1) < 15 ? (wid + T1) : 15;
        u32x4 pw; pw[0] = cvtpk(S[T0][0], S[T0][1]); pw[1] = cvtpk(S[T0][2], S[T0][3]); pw[2] = cvtpk(S[T1][0], S[T1][1]); pw[3] = cvtpk(S[T1][2], S[T1][3]);
        const bf16x8 pf = __builtin_bit_cast(bf16x8, pw);
        const unsigned a0 = vbase + (16 * t0i + 4 * fq + (fr >> 2)) * 160 + 4 * (fr & 3) * 2;
        const unsigned a1 = vbase + (16 * t1i + 4 * fq + (fr >> 2)) * 160 + 4 * (fr & 3) * 2;
        s16x4 vr[8]; tr_read8(a0, a1, vr);
#pragma unroll
        for (int dt = 0; dt < 4; ++dt) {
          const s16x4 v0 = vr[2 * dt], v1 = vr[2 * dt + 1];
          bf16x8 vf; vf[0] = v0[0]; vf[1] = v0[1]; vf[2] = v0[2]; vf[3] = v0[3]; vf[4] = v1[0]; vf[5] = v1[1]; vf[6] = v1[2]; vf[7] = v1[3];
          O[dt] = __builtin_amdgcn_mfma_f32_16x16x32_bf16(vf, pf, O[dt], 0, 0, 0);
        }
      }
      const float inv = 1.0f / l;
      bf16_t* op = (br < 2 ? (bf16_t*)(p.ws + OFF_OP01) + (size_t)br * NTOK * 512 : (bf16_t*)(p.ws + OFF_OP2)) + tokq * 512 + h * 64 + 4 * fq;
#pragma unroll
      for (int dt = 0; dt < 4; ++dt) {
        const f32x4 o = O[dt] * inv;
        u32x2 w; w[0] = cvtpk(o[0], o[1]); w[1] = cvtpk(o[2], o[3]);
        *(u32x2*)(op + 16 * dt) = w;
      }
      if (fq == 0) LSE[((size_t)br * NTOK + tokq) * 8 + h] = mx + __builtin_amdgcn_logf(l);
    }
    __syncthreads();
    if (nxt < NITEM) stage_write();
    qc0 = qn0; qc1 = qn1;
    __syncthreads();
  }
}

__device__ void attn_merge_phase(const Params& p) {
  THREAD_IDS
  const float* LSE = (const float*)(p.ws + OFF_LSE);
  bf16_t* MIX = (bf16_t*)(p.ws + OFF_MIX);
  const f32x4 g0 = *(const f32x4*)(p.out_norm_b_g + lane * 8), g1 = *(const f32x4*)(p.out_norm_b_g + lane * 8 + 4);
  const int h = lane >> 3, tstep = gridDim.x * 8;
  float ln[3], scn; u32x4 an, bn, cn;
  auto ld = [&](int t) {
    ln[0] = LSE[((size_t)0 * NTOK + t) * 8 + h]; ln[1] = LSE[((size_t)1 * NTOK + t) * 8 + h]; ln[2] = LSE[((size_t)2 * NTOK + t) * 8 + h];
    an = *(const u32x4*)((const bf16_t*)(p.ws + OFF_OP01) + (size_t)t * 512 + lane * 8);
    bn = *(const u32x4*)((const bf16_t*)(p.ws + OFF_OP01) + ((size_t)NTOK + t) * 512 + lane * 8);
    cn = *(const u32x4*)((const bf16_t*)(p.ws + OFF_OP2) + (size_t)t * 512 + lane * 8);
    scn = ((const float*)(p.ws + OFF_SAM))[t];
  };
  ld(blockIdx.x * 8 + wid);
  for (int t = blockIdx.x * 8 + wid; t < NTOK; t += tstep) {
    const float l0 = ln[0], l1 = ln[1], l2 = ln[2];
    const u32x4 a = an, b = bn, c = cn; const float scale = scn;
    if (t + tstep < NTOK) ld(t + tstep);
    const float mx = fmaxf(l0, fmaxf(l1, l2));
    float w0 = __builtin_amdgcn_exp2f(l0 - mx), w1 = __builtin_amdgcn_exp2f(l1 - mx), w2 = __builtin_amdgcn_exp2f(l2 - mx);
    const float inv = 1.0f / (w0 + w1 + w2); w0 *= inv; w1 *= inv; w2 *= inv;
    float o[8]; float ss = 0.f;
#pragma unroll
    for (int j = 0; j < 4; ++j) {
      o[2 * j] = w0 * bf_lo(a[j]) + w1 * bf_lo(b[j]) + w2 * bf_lo(c[j]);
      o[2 * j + 1] = w0 * bf_hi(a[j]) + w1 * bf_hi(b[j]) + w2 * bf_hi(c[j]);
      ss += o[2 * j] * o[2 * j] + o[2 * j + 1] * o[2 * j + 1];
    }
    ss = wave_sum(ss);
    const float rs = rsqrtf(ss * (1.0f / 512.0f) + EPS);
    const float qs = scale > 0.f ? 1.0f / scale : 0.f;
    float vb[8];
#pragma unroll
    for (int j = 0; j < 8; ++j) vb[j] = fminf(fmaxf(o[j] * rs * (j < 4 ? g0[j & 3] : g1[j & 3]) * qs, -127.0f), 127.0f);
    u32x2 qb;
#pragma unroll
    for (int e = 0; e < 2; ++e)
      qb[e] = ((unsigned)__float2int_rn(vb[4 * e]) & 0xffu) | (((unsigned)__float2int_rn(vb[4 * e + 1]) & 0xffu) << 8) | (((unsigned)__float2int_rn(vb[4 * e + 2]) & 0xffu) << 16) | ((unsigned)__float2int_rn(vb[4 * e + 3]) << 24);
    *(u32x2*)(p.ws + OFF_MIX8 + (size_t)t * DM + 512 + lane * 8) = qb;
  }
}

__device__ __forceinline__ void tr_read8s(unsigned a0, s16x4 (&r)[8]) {
  asm volatile("ds_read_b64_tr_b16 %0, %8\n\tds_read_b64_tr_b16 %1, %8 offset:4224\n\tds_read_b64_tr_b16 %2, %8 offset:32\n\tds_read_b64_tr_b16 %3, %8 offset:4256\n\t"
               "ds_read_b64_tr_b16 %4, %8 offset:64\n\tds_read_b64_tr_b16 %5, %8 offset:4288\n\tds_read_b64_tr_b16 %6, %8 offset:96\n\tds_read_b64_tr_b16 %7, %8 offset:4320\n\ts_waitcnt lgkmcnt(0)"
               : "=&v"(r[0]), "=&v"(r[1]), "=&v"(r[2]), "=&v"(r[3]), "=&v"(r[4]), "=&v"(r[5]), "=&v"(r[6]), "=&v"(r[7]) : "v"(a0) : "memory");
}
__device__ void spatial_item(const Params& p, int item, unsigned char* smem) {
  THREAD_IDS const int fr = lane & 15, fq = lane >> 4;
  const bf16_t* P = (const bf16_t*)(p.ws + OFF_P);
  const bf16_t* WSP = (const bf16_t*)(p.ws + OFF_WSP);
  bf16_t* MIX = (bf16_t*)(p.ws + OFF_MIX);
  const size_t t0 = (size_t)item * 128;
  constexpr int YS = 1056;
  const unsigned ybase = (unsigned)(uintptr_t)(__attribute__((address_space(3))) unsigned char*)smem;
  __syncthreads();
  {
    const f32x4 g0 = *(const f32x4*)(p.ln_v_g + lane * 8), g1 = *(const f32x4*)(p.ln_v_g + lane * 8 + 4);
    const f32x4 b0 = *(const f32x4*)(p.ln_v_b + lane * 8), b1 = *(const f32x4*)(p.ln_v_b + lane * 8 + 4);
    for (int r4 = 0; r4 < 4; ++r4) {
      u32x4 w[4];
#pragma unroll
      for (int q = 0; q < 4; ++q) w[q] = *(const u32x4*)(P + (t0 + wid * 16 + r4 * 4 + q) * DIN + 512 + lane * 8);
      float v[4][8], s1[4], s2[4];
#pragma unroll
      for (int q = 0; q < 4; ++q) {
        s1[q] = 0.f; s2[q] = 0.f;
#pragma unroll
        for (int j = 0; j < 4; ++j) { v[q][2 * j] = bf_lo(w[q][j]); v[q][2 * j + 1] = bf_hi(w[q][j]); }
#pragma unroll
        for (int i = 0; i < 8; ++i) { s1[q] += v[q][i]; s2[q] += v[q][i] * v[q][i]; }
      }
#pragma unroll
      for (int q = 0; q < 4; ++q) { s1[q] = wave_sum(s1[q]); s2[q] = wave_sum(s2[q]); }
#pragma unroll
      for (int q = 0; q < 4; ++q) {
        const float mean = s1[q] * (1.0f / 512.0f), var = fmaxf(s2[q] * (1.0f / 512.0f) - mean * mean, 0.f), rs = rsqrtf(var + EPS);
        u32x4 o;
        o[0] = cvtpk((v[q][0] - mean) * rs * g0[0] + b0[0], (v[q][1] - mean) * rs * g0[1] + b0[1]); o[1] = cvtpk((v[q][2] - mean) * rs * g0[2] + b0[2], (v[q][3] - mean) * rs * g0[3] + b0[3]);
        o[2] = cvtpk((v[q][4] - mean) * rs * g1[0] + b1[0], (v[q][5] - mean) * rs * g1[1] + b1[1]); o[3] = cvtpk((v[q][6] - mean) * rs * g1[2] + b1[2], (v[q][7] - mean) * rs * g1[3] + b1[3]);
        *(u32x4*)(smem + (wid * 16 + r4 * 4 + q) * YS + lane * 16) = o;
      }
    }
  }
  __syncthreads();
  const size_t tp = t0 + wid * 16 + fr;
  float ss = 0.f;
  unsigned keep[8][4][2];
#pragma unroll
  for (int g = 0; g < 8; ++g) {
    bf16x8 bfr[4];
#pragma unroll
    for (int ks = 0; ks < 4; ++ks) bfr[ks] = *(const bf16x8*)(WSP + (size_t)(g * 128 + wid * 16 + fr) * 128 + 32 * ks + 8 * fq);
    const float bias = p.b_spatial[g * 128 + wid * 16 + fr];
    u32x2 uw[4];
#pragma unroll
    for (int ct = 0; ct < 4; ++ct) uw[ct] = *(const u32x2*)(P + tp * DIN + 64 * g + 16 * ct + 4 * fq);
    f32x4 acc[4];
#pragma unroll
    for (int ct = 0; ct < 4; ++ct) acc[ct] = (f32x4){0.f, 0.f, 0.f, 0.f};
#pragma unroll
    for (int ks = 0; ks < 4; ++ks) {
      const unsigned a0 = ybase + (32 * ks + 8 * fq + (fr >> 2)) * YS + (64 * g + 4 * (fr & 3)) * 2;
      s16x4 vr[8]; tr_read8s(a0, vr);
#pragma unroll
      for (int ct = 0; ct < 4; ++ct) {
        const s16x4 v0 = vr[2 * ct], v1 = vr[2 * ct + 1];
        bf16x8 af; af[0] = v0[0]; af[1] = v0[1]; af[2] = v0[2]; af[3] = v0[3]; af[4] = v1[0]; af[5] = v1[1]; af[6] = v1[2]; af[7] = v1[3];
        acc[ct] = __builtin_amdgcn_mfma_f32_16x16x32_bf16(af, bfr[ks], acc[ct], 0, 0, 0);
      }
    }
#pragma unroll
    for (int ct = 0; ct < 4; ++ct) {
      f32x4 a;
      a[0] = bf_lo(uw[ct][0]) * (acc[ct][0] + bias); a[1] = bf_hi(uw[ct][0]) * (acc[ct][1] + bias); a[2] = bf_lo(uw[ct][1]) * (acc[ct][2] + bias); a[3] = bf_hi(uw[ct][1]) * (acc[ct][3] + bias);
      ss += a[0] * a[0] + a[1] * a[1] + a[2] * a[2] + a[3] * a[3];
      keep[g][ct][0] = cvtpk(a[0], a[1]); keep[g][ct][1] = cvtpk(a[2], a[3]);
    }
  }
  ss = sum_x32(sum_x16(ss));
  const float rs = rsqrtf(ss * (1.0f / 512.0f) + EPS);
  float am = 0.f;
#pragma unroll
  for (int g = 0; g < 8; ++g)
#pragma unroll
    for (int ct = 0; ct < 4; ++ct) {
      const f32x4 gm = *(const f32x4*)(p.out_norm_a_g + 64 * g + 16 * ct + 4 * fq);
      am = fmaxf(am, fmaxf(fmaxf(fabsf(bf_lo(keep[g][ct][0]) * gm[0]), fabsf(bf_hi(keep[g][ct][0]) * gm[1])), fmaxf(fabsf(bf_lo(keep[g][ct][1]) * gm[2]), fabsf(bf_hi(keep[g][ct][1]) * gm[3]))));
    }
  am = max_x32(max_x16(am)) * rs;
  float gbm = 0.f;
  { const f32x4 b0 = *(const f32x4*)(p.out_norm_b_g + lane * 8), b1 = *(const f32x4*)(p.out_norm_b_g + lane * 8 + 4);
    gbm = wave_max(fmaxf(fmaxf(fmaxf(fabsf(b0[0]), fabsf(b0[1])), fmaxf(fabsf(b0[2]), fabsf(b0[3]))), fmaxf(fmaxf(fabsf(b1[0]), fabsf(b1[1])), fmaxf(fabsf(b1[2]), fabsf(b1[3]))))); }
  const float top = fmaxf(am, 4.0f * gbm), qs = top > 0.f ? 127.0f / top : 0.f;
  if (fq == 0) ((float*)(p.ws + OFF_SAM))[tp] = top * (1.0f / 127.0f);
#pragma unroll
  for (int g = 0; g < 8; ++g)
#pragma unroll
    for (int ct = 0; ct < 4; ++ct) {
      const int ch = 64 * g + 16 * ct + 4 * fq;
      const f32x4 gm = *(const f32x4*)(p.out_norm_a_g + ch);
      const float sc = rs * qs;
      const unsigned q = ((unsigned)__float2int_rn(bf_lo(keep[g][ct][0]) * gm[0] * sc) & 0xffu) | (((unsigned)__float2int_rn(bf_hi(keep[g][ct][0]) * gm[1] * sc) & 0xffu) << 8)
                       | (((unsigned)__float2int_rn(bf_lo(keep[g][ct][1]) * gm[2] * sc) & 0xffu) << 16) | ((unsigned)__float2int_rn(bf_hi(keep[g][ct][1]) * gm[3] * sc) << 24);
      *(unsigned*)(p.ws + OFF_MIX8 + tp * DM + ch) = q;
    }
  __syncthreads();
}

template <int NCH> __device__ void quant_weight_rows(const bf16_t* W, unsigned char* W8, float* SC, int N) {
  THREAD_IDS
  for (int r = blockIdx.x * 8 + wid; r < N; r += gridDim.x * 8) {
    u32x4 w[NCH]; float am = 0.f;
#pragma unroll
    for (int c = 0; c < NCH; ++c) {
      w[c] = *(const u32x4*)(W + (size_t)r * (512 * NCH) + c * 512 + lane * 8);
#pragma unroll
      for (int j = 0; j < 4; ++j) am = fmaxf(am, fmaxf(fabsf(bf_lo(w[c][j])), fabsf(bf_hi(w[c][j]))));
    }
    am = wave_max(am);
    const float qs = am > 0.f ? 127.0f / am : 0.f;
#pragma unroll
    for (int c = 0; c < NCH; ++c) {
      u32x2 q;
#pragma unroll
      for (int e = 0; e < 2; ++e)
        q[e] = ((unsigned)__float2int_rn(bf_lo(w[c][2 * e]) * qs) & 0xffu) | (((unsigned)__float2int_rn(bf_hi(w[c][2 * e]) * qs) & 0xffu) << 8) | (((unsigned)__float2int_rn(bf_lo(w[c][2 * e + 1]) * qs) & 0xffu) << 16) | ((unsigned)__float2int_rn(bf_hi(w[c][2 * e + 1]) * qs) << 24);
      *(u32x2*)(W8 + (size_t)r * (512 * NCH) + c * 512 + lane * 8) = q;
    }
    if (lane == 0) SC[r] = am * (1.0f / 127.0f);
  }
}

__device__ void phase_xn(const Params& p) {
  THREAD_IDS
  float* RS = (float*)(p.ws + OFF_RS);
  float* SX = (float*)(p.ws + OFF_SX);
  const int rstep = gridDim.x * 8;
  u32x4 wn[2];
  { const bf16_t* xr = (const bf16_t*)(p.ws + OFF_X1B) + (size_t)(blockIdx.x * 8 + wid) * DM; wn[0] = *(const u32x4*)(xr + lane * 8); wn[1] = *(const u32x4*)(xr + 512 + lane * 8); }
  for (int row = blockIdx.x * 8 + wid; row < NTOK; row += rstep) {
    f32x4 v[4]; float ss = 0.f;
    const u32x4 wc2[2] = {wn[0], wn[1]};
    if (row + rstep < NTOK) { const bf16_t* xr = (const bf16_t*)(p.ws + OFF_X1B) + (size_t)(row + rstep) * DM; wn[0] = *(const u32x4*)(xr + lane * 8); wn[1] = *(const u32x4*)(xr + 512 + lane * 8); }
#pragma unroll
    for (int hf = 0; hf < 2; ++hf) {
      const u32x4 w = wc2[hf];
      v[2 * hf] = (f32x4){bf_lo(w[0]), bf_hi(w[0]), bf_lo(w[1]), bf_hi(w[1])}; v[2 * hf + 1] = (f32x4){bf_lo(w[2]), bf_hi(w[2]), bf_lo(w[3]), bf_hi(w[3])};
    }
#pragma unroll
    for (int i = 0; i < 4; ++i) ss += v[i][0] * v[i][0] + v[i][1] * v[i][1] + v[i][2] * v[i][2] + v[i][3] * v[i][3];
    ss = wave_sum(ss);
    const float rs = rsqrtf(ss * (1.0f / DM) + EPS);
    if (lane == 0) RS[row] = rs;
    {
      float am = 0.f;
#pragma unroll
      for (int i = 0; i < 4; ++i) am = fmaxf(am, fmaxf(fmaxf(fabsf(v[i][0]), fabsf(v[i][1])), fmaxf(fabsf(v[i][2]), fabsf(v[i][3]))));
      am = wave_max(am);
      const float qs = am > 0.f ? 119.0f / am : 0.f, sx = am * (1.0f / 119.0f) * rs;
#pragma unroll
      for (int hf = 0; hf < 2; ++hf) {
        u32x2 q; int qsum = 0;
#pragma unroll
        for (int e = 0; e < 2; ++e) {
          const f32x4 a = v[2 * hf + e] * qs;
          const int q0 = __float2int_rn(a[0]), q1 = __float2int_rn(a[1]), q2 = __float2int_rn(a[2]), q3 = __float2int_rn(a[3]);
          qsum += q0 + q1 + q2 + q3;
          q[e] = ((unsigned)q0 & 0xffu) | (((unsigned)q1 & 0xffu) << 8) | (((unsigned)q2 & 0xffu) << 16) | ((unsigned)q3 << 24);
        }
        *(u32x2*)(p.ws + OFF_X8 + (size_t)row * DM + hf * 512 + lane * 8) = q;
        const float cs = sum_x16(sum16((float)qsum));
        if ((lane & 31) == 0) *(f32x2*)(SX + ((size_t)row * 4 + 2 * hf + (lane >> 5)) * 2) = (f32x2){sx, 0.5f * sx * cs};
      }
      if (lane == 0) ((float*)(p.ws + OFF_SA8))[row] = am * (1.0f / 119.0f);
    }
  }
}

__device__ __forceinline__ unsigned xcc_id() { return (unsigned)__builtin_amdgcn_s_getreg((3 << 11) | 20) & 7u; }
constexpr int ITEM_TOK = 16;
template <int NP, class F> __device__ __forceinline__ void run_queue(unsigned* qbase, F&& body) {
  THREAD_IDS
  const int myp = (int)xcc_id() & (NP - 1);
  int k = 0;
  unsigned idx = 0;
  if (lane == 0) idx = __hip_atomic_fetch_add(qbase + myp * 32, 1u, __ATOMIC_RELAXED, __HIP_MEMORY_SCOPE_AGENT);
  while (k < NP) {
    const int part = (myp + k) & (NP - 1);
    const unsigned cur = (unsigned)__builtin_amdgcn_readfirstlane((int)idx);
    if (cur >= (unsigned)(NTOK / ITEM_TOK)) {
      ++k;
      if (k < NP && lane == 0) idx = __hip_atomic_fetch_add(qbase + ((myp + k) & (NP - 1)) * 32, 1u, __ATOMIC_RELAXED, __HIP_MEMORY_SCOPE_AGENT);
      continue;
    }
    if (lane == 0) idx = __hip_atomic_fetch_add(qbase + part * 32, 1u, __ATOMIC_RELAXED, __HIP_MEMORY_SCOPE_AGENT);
    body(part, (int)cur);
  }
}

template <int CTRL> __device__ __forceinline__ int dppi(int x) { return __builtin_amdgcn_mov_dpp(x, CTRL, 0xf, 0xf, true); }
__device__ __forceinline__ int isum8(int s) { s += dppi<0xB1>(s); s += dppi<0x4E>(s); s += dppi<0x141>(s); return s; }
__device__ void phase_udot(const Params& p, int qoff) {
  THREAD_IDS const int g = lane >> 3, sub = lane & 7;
  const unsigned char* XQ = p.ws + OFF_X8;
  const f32x2* SX = (const f32x2*)(p.ws + OFF_SX);
  const unsigned short* SELE = (const unsigned short*)(p.ws + OFF_SELE);
  unsigned* PD = (unsigned*)(p.ws + OFF_PD);
  run_queue<4>((unsigned*)(p.ws + OFF_Q) + qoff, [&](int part, int idx) {
    const unsigned char* EU = p.ws + OFF_EU + (size_t)part * SLICE + sub * 16;
    const int t0 = idx * ITEM_TOK;
    u32x4 ev[3][2], xb0[2], xb1[2], rw[2][16]; f32x2 sxv[2];
    auto ld_e = [&](int tt) {
#pragma unroll
      for (int i = 0; i < 2; ++i) ev[tt % 3][i] = *(const u32x4*)(SELE + (size_t)(t0 + tt) * 128 + g * 16 + 8 * i);
    };
    auto ld_x = [&](int tt) {
      const unsigned char* xr = XQ + (size_t)(t0 + tt) * DM + part * 256 + sub * 32;
      xb0[tt & 1] = *(const u32x4*)xr; xb1[tt & 1] = *(const u32x4*)(xr + 16);
      sxv[tt & 1] = SX[(size_t)(t0 + tt) * 4 + part];
    };
    auto ld_rows = [&](int tt) {
#pragma unroll
      for (int b = 0; b < 16; ++b) rw[tt & 1][b] = *(const u32x4*)(EU + (size_t)((ev[tt % 3][b >> 3][(b >> 1) & 3] >> (16 * (b & 1))) & 0xffffu) * 128);
    };
    auto reduce = [&](int tt) {
      unsigned xh[4], xl[4];
#pragma unroll
      for (int j = 0; j < 4; ++j) {
        const unsigned w0 = j < 2 ? xb0[tt & 1][2 * j] : xb1[tt & 1][2 * j - 4], w1 = j < 2 ? xb0[tt & 1][2 * j + 1] : xb1[tt & 1][2 * j - 3];
        const unsigned v0 = ((w0 ^ 0x80808080u) + 0x08080808u) ^ 0x88888888u, v1 = ((w1 ^ 0x80808080u) + 0x08080808u) ^ 0x88888888u;
        xl[j] = (v0 & 0x0f0f0f0fu) | ((v1 & 0x0f0f0f0fu) << 4);
        xh[j] = ((v0 >> 4) & 0x0f0f0f0fu) | (v1 & 0xf0f0f0f0u);
      }
      int k0 = 0, k1 = 0;
#pragma unroll
      for (int b = 0; b < 16; ++b) {
        int dh = 0, dl = 0;
#pragma unroll
        for (int j = 0; j < 4; ++j) { dh = __builtin_amdgcn_sdot8((int)rw[tt & 1][b][j], (int)xh[j], dh, false); dl = __builtin_amdgcn_sdot8((int)rw[tt & 1][b][j], (int)xl[j], dl, false); }
        const int d = isum8(dh * 16 + dl);
        if (b & 1) k1 = (sub == (b >> 1)) ? d : k1; else k0 = (sub == (b >> 1)) ? d : k0;
      }
      PD[((size_t)(t0 + tt) * 4 + part) * 64 + g * 8 + sub] = cvtpk((float)k0 * sxv[tt & 1][0] + sxv[tt & 1][1], (float)k1 * sxv[tt & 1][0] + sxv[tt & 1][1]);
    };
    ld_e(0); ld_e(1); ld_e(2); ld_x(0); ld_rows(0);
#pragma unroll
    for (int tt = 0; tt < ITEM_TOK; ++tt) {
      if (tt + 1 < ITEM_TOK) { ld_rows(tt + 1); ld_x(tt + 1); }
      if (tt + 3 < ITEM_TOK) ld_e(tt + 3);
      reduce(tt);
    }
  });
}

__device__ __forceinline__ unsigned quant_coef(float c, unsigned E) {
  const float x = fabsf(c) * __uint_as_float((255u - E) << 23);
  const unsigned m = x < 0.25f ? 0u : x < 0.75f ? 1u : x < 1.25f ? 2u : x < 1.75f ? 3u : x < 2.5f ? 4u : x < 3.5f ? 5u : 6u;
  return ((E - 1u) << 8) | m | ((__float_as_uint(c) >> 28) & 8u);
}
__device__ void phase_coef(const Params& p) {
  const unsigned* SELE2 = (const unsigned*)(p.ws + OFF_SELE);
  const f32x2* SELG2 = (const f32x2*)(p.ws + OFF_SELG);
  const unsigned* PD = (const unsigned*)(p.ws + OFF_PD);
  const f32x2* SCL = (const f32x2*)(p.ws + OFF_SCL);
  const f32x4* SCLU = (const f32x4*)(p.ws + OFF_SCLU);
  unsigned* CQ = (unsigned*)(p.ws + OFF_CQ);
  THREAD_IDS
  const size_t istep = (size_t)gridDim.x * NTHREADS, iend = (size_t)NTOK * 64;
  unsigned pdn[4], e2n; f32x2 gtn;
  auto ld = [&](size_t i) {
    const size_t t = i >> 6; const int sp = (int)(i & 63);
#pragma unroll
    for (int q = 0; q < 4; ++q) pdn[q] = PD[(t * 4 + q) * 64 + sp];
    e2n = SELE2[i]; gtn = SELG2[i];
  };
  size_t i = (size_t)blockIdx.x * NTHREADS + tid;
  if (i < iend) ld(i);
  for (; i < iend; i += istep) {
    unsigned pd[4];
#pragma unroll
    for (int q = 0; q < 4; ++q) pd[q] = pdn[q];
    const unsigned e2 = e2n; const f32x2 gt = gtn;
    const float sv0 = SCL[e2 & 0xffffu][1], sv1 = SCL[e2 >> 16][1];
    const f32x4 su0 = SCLU[e2 & 0xffffu], su1 = SCLU[e2 >> 16];
    if (i + istep < iend) ld(i + istep);
    float s0 = 0.f, s1 = 0.f;
#pragma unroll
    for (int q = 0; q < 4; ++q) { s0 += bf_lo(pd[q]) * su0[q]; s1 += bf_hi(pd[q]) * su1[q]; }
    const float c0 = gt[0] * gelu_tanh(s0) * sv0, c1 = gt[1] * gelu_tanh(s1) * sv1;
    const unsigned e0 = (__float_as_uint(c0) >> 23) & 255u, e1 = (__float_as_uint(c1) >> 23) & 255u;
    const unsigned E0 = max(max(e0, (unsigned)dppi<0x128>((int)e0)), 1u), E1 = max(max(e1, (unsigned)dppi<0x128>((int)e1)), 1u);
    CQ[i] = quant_coef(c0, E0) | (quant_coef(c1, E1) << 16);
  }
}

__device__ void phase_vsum(const Params& p) {
  THREAD_IDS const int g = lane >> 3, sub = lane & 7, kg = lane >> 4;
  const unsigned short* SELE = (const unsigned short*)(p.ws + OFF_SELE);
  const unsigned char* CQ = p.ws + OFF_CQ;
  float* SS = (float*)(p.ws + OFF_SS);
  const bool lo8 = (lane & 8) == 0;
  const int jsh = 4 * (lane & 7);
  int one_scale = 0x7f7f7f7f; asm volatile("" : "+v"(one_scale));
  run_queue<4>((unsigned*)(p.ws + OFF_Q) + 8 * 32, [&](int part, int idx) {
    const unsigned char* EV = p.ws + OFF_EV + (size_t)part * SLICE + sub * 16;
    const int t0 = idx * ITEM_TOK;
    u32x4 ev[3][2], rw[2][16], ca[2][2], cb[2][2];
    auto ld_e = [&](int tt) {
#pragma unroll
      for (int i = 0; i < 2; ++i) ev[tt % 3][i] = *(const u32x4*)(SELE + (size_t)(t0 + tt) * 128 + g * 16 + 8 * i);
    };
    auto ld_c = [&](int tt) {
      const unsigned char* c = CQ + (size_t)(t0 + tt) * 256 + kg * 64;
      ca[tt & 1][0] = *(const u32x4*)c; ca[tt & 1][1] = *(const u32x4*)(c + 16); cb[tt & 1][0] = *(const u32x4*)(c + 32); cb[tt & 1][1] = *(const u32x4*)(c + 48);
    };
    auto ld_rows = [&](int tt) {
#pragma unroll
      for (int b = 0; b < 16; ++b) rw[tt & 1][b] = *(const u32x4*)(EV + (size_t)((ev[tt % 3][b >> 3][(b >> 1) & 3] >> (16 * (b & 1))) & 0xffffu) * 128);
    };
    auto reduce = [&](int tt) {
      const int t = t0 + tt;
      f32x4 acc0 = (f32x4){0.f, 0.f, 0.f, 0.f}, acc1 = acc0, acc2 = acc0, acc3 = acc0;
#pragma unroll
      for (int b = 0; b < 16; ++b) {
        const u32x4 w = rw[tt & 1][b];
        const unsigned qa = ca[tt & 1][b >> 3][(b >> 1) & 3] >> (16 * (b & 1)), qb = cb[tt & 1][b >> 3][(b >> 1) & 3] >> (16 * (b & 1));
        const unsigned da = (qa & 15u) << jsh, db = (qb & 15u) << jsh;
        const int sc = (int)(((qa >> 8) & 255u) * 0x01010101u);
        const i32x8v B = {(int)(lo8 ? da : 0u), (int)(lo8 ? 0u : da), (int)(lo8 ? db : 0u), (int)(lo8 ? 0u : db), 0, 0, 0, 0};
        const i32x8v A0 = {(int)(lo8 ? w[0] : 0u), (int)(lo8 ? w[1] : 0u), (int)(lo8 ? 0u : w[0]), (int)(lo8 ? 0u : w[1]), 0, 0, 0, 0};
        const i32x8v A1 = {(int)(lo8 ? w[2] : 0u), (int)(lo8 ? w[3] : 0u), (int)(lo8 ? 0u : w[2]), (int)(lo8 ? 0u : w[3]), 0, 0, 0, 0};
        if (b & 1) {
          acc2 = __builtin_amdgcn_mfma_scale_f32_16x16x128_f8f6f4(A0, B, acc2, 4, 4, 0, one_scale, 0, sc);
          acc3 = __builtin_amdgcn_mfma_scale_f32_16x16x128_f8f6f4(A1, B, acc3, 4, 4, 0, one_scale, 0, sc);
        } else {
          acc0 = __builtin_amdgcn_mfma_scale_f32_16x16x128_f8f6f4(A0, B, acc0, 4, 4, 0, one_scale, 0, sc);
          acc1 = __builtin_amdgcn_mfma_scale_f32_16x16x128_f8f6f4(A1, B, acc1, 4, 4, 0, one_scale, 0, sc);
        }
      }
      acc0 += acc2; acc1 += acc3;
      float r[4];
#pragma unroll
      for (int q = 0; q < 4; ++q) {
        const auto sw = __builtin_amdgcn_permlane32_swap(__float_as_uint(acc0[q]), __float_as_uint(acc1[q]), false, false);
        r[q] = __uint_as_float(sw[0]) + __uint_as_float(sw[1]);
      }
      {
        const int d0 = part * 256 + ((lane >> 4) & 1) * 128 + (lane >> 5) * 16 + (lane & 15);
        const bf16_t* x1 = (const bf16_t*)(p.ws + OFF_X1B) + (size_t)t * DM + d0;
        float v[4], pv[4], ss = 0.f;
#pragma unroll
        for (int q = 0; q < 4; ++q) { v[q] = __uint_as_float((unsigned)x1[32 * q] << 16) + r[q]; ss += v[q] * v[q]; pv[q] = dppf<0xB1>(v[q]); }
        const bool odd = (lane & 1) != 0;
        unsigned* o = (unsigned*)((bf16_t*)(p.ws + OFF_X2B) + (size_t)t * DM + (d0 & ~1) + (odd ? 64 : 0));
        o[0] = cvtpk(odd ? pv[2] : v[0], odd ? v[2] : pv[0]);
        o[16] = cvtpk(odd ? pv[3] : v[1], odd ? v[3] : pv[1]);
        ss = wave_sum(ss);
        if (lane == 0) atomicAdd(SS + t, ss);
      }
    };
    ld_e(0); ld_e(1); ld_e(2); ld_c(0); ld_rows(0);
#pragma unroll
    for (int tt = 0; tt < ITEM_TOK; ++tt) {
      if (tt + 1 < ITEM_TOK) { ld_rows(tt + 1); ld_c(tt + 1); }
      if (tt + 3 < ITEM_TOK) ld_e(tt + 3);
      reduce(tt);
    }
  });
}

__device__ void phase_final(const Params& p) {
  THREAD_IDS
  const float* SS = (const float*)(p.ws + OFF_SS);
  f32x4 gf[4];
#pragma unroll
  for (int i = 0; i < 4; ++i) gf[i] = *(const f32x4*)(p.final_norm_g + i * 256 + lane * 4);
  const int tstep = gridDim.x * 8;
  const bf16_t* X2 = (const bf16_t*)(p.ws + OFF_X2B);
  u32x2 vn[4]; float ssn;
  { const int t0 = blockIdx.x * 8 + wid; ssn = SS[t0];
#pragma unroll
    for (int i = 0; i < 4; ++i) vn[i] = *(const u32x2*)(X2 + (size_t)t0 * DM + i * 256 + lane * 4); }
  for (int t = blockIdx.x * 8 + wid; t < NTOK; t += tstep) {
    const float rs = rsqrtf(ssn * (1.0f / DM) + EPS);
    f32x4 v[4];
#pragma unroll
    for (int i = 0; i < 4; ++i) v[i] = (f32x4){bf_lo(vn[i][0]), bf_hi(vn[i][0]), bf_lo(vn[i][1]), bf_hi(vn[i][1])};
    if (t + tstep < NTOK) { ssn = SS[t + tstep];
#pragma unroll
      for (int i = 0; i < 4; ++i) vn[i] = *(const u32x2*)(X2 + (size_t)(t + tstep) * DM + i * 256 + lane * 4); }
    float* xr = p.out + (size_t)t * DM;
#pragma unroll
    for (int i = 0; i < 4; ++i) *(f32x4*)(xr + i * 256 + lane * 4) = v[i] * gf[i] * rs;
  }
}

#define XB_TMO      128
#define XB_XCNT(j)  (256  + 64 * (j))
#define XB_XSUB(j)  (1280 + 64 * (j))
#define XB_XGEN(j)  (2304 + 64 * (j))
#define XB_TOP      3328
#define XB_TOPGEN   3392
#define XCD_BAR_WORDS 3456
#define XB_SPIN_CAP (1u << 18)
#define LAS __attribute__((address_space(3)))
__device__ __forceinline__ unsigned xb_ld(unsigned* p)              { return __hip_atomic_load(p, __ATOMIC_RELAXED, __HIP_MEMORY_SCOPE_AGENT); }
__device__ __forceinline__ unsigned xb_add(unsigned* p, unsigned v) { return __hip_atomic_fetch_add(p, v, __ATOMIC_RELAXED, __HIP_MEMORY_SCOPE_AGENT); }
__device__ __forceinline__ unsigned xb_xcc_id() { return (unsigned)__builtin_amdgcn_s_getreg((3 << 11) | 20) & 0xFu; }
#define XB_SPIN(cond, bar) do { unsigned _sp = 0; while (cond) { __builtin_amdgcn_s_sleep(1); \
    if ((++_sp & 255u) == 0u) { if (xb_ld(&(bar)[XB_TMO])) break; if (_sp > XB_SPIN_CAP) { atomicAdd(&(bar)[XB_TMO], 1u); break; } } } } while (0)
struct XcdBarrier { unsigned* bar; unsigned x; volatile LAS unsigned* st; };
__device__ __forceinline__ XcdBarrier xcd_barrier_post(unsigned* bar, volatile LAS unsigned* st) {
    XcdBarrier b; b.bar = bar; b.x = xb_xcc_id(); b.st = st;
    if (threadIdx.x == 0) (void)xb_add(&bar[XB_XCNT(b.x)], 1u);
    return b;
}
__device__ __forceinline__ void xcd_barrier_complete(unsigned* bar, unsigned x, unsigned& nloc, unsigned& nx) {
    const unsigned G = gridDim.x * gridDim.y * gridDim.z;
    unsigned sum, cnt, mine, sp = 0u;
    for (;;) {
        sum = 0u; cnt = 0u; mine = 0u;
#pragma unroll
        for (unsigned j = 0; j < 16; ++j) { const unsigned c = xb_ld(&bar[XB_XCNT(j)]); sum += c; cnt += (c > 0u) ? 1u : 0u; mine = (j == x) ? c : mine; }
        if (sum == G) break;
        __builtin_amdgcn_s_sleep(1);
        if ((++sp & 255u) == 0u) { if (xb_ld(&bar[XB_TMO])) break; if (sp > XB_SPIN_CAP) { atomicAdd(&bar[XB_TMO], 1u); break; } }
    }
    nloc = mine > 0u ? mine : 1u; nx = cnt > 0u ? cnt : 1u;
}
__device__ __forceinline__ void xcd_barrier(const XcdBarrier& b) {
    asm volatile("s_waitcnt vmcnt(0)" ::: "memory");
    __syncthreads();
    if (threadIdx.x == 0) {
        unsigned* bar = b.bar;
        __builtin_amdgcn_s_waitcnt(0);
        unsigned nloc = b.st[0], nx = b.st[1];
        if (nloc == 0u) { xcd_barrier_complete(bar, b.x, nloc, nx); b.st[0] = nloc; b.st[1] = nx; }
        const unsigned old = xb_add(&bar[XB_XSUB(b.x)], 1u);
        const unsigned gen = old / nloc;
        if (old + 1u == (gen + 1u) * nloc) {
            __builtin_amdgcn_fence(__ATOMIC_RELEASE, "agent");
            asm volatile("s_waitcnt vmcnt(0)" ::: "memory");
            const unsigned og = xb_add(&bar[XB_TOP], 1u);
            const unsigned tg = og / nx;
            if (og + 1u == (tg + 1u) * nx) xb_add(&bar[XB_TOPGEN], 1u);
            else XB_SPIN(xb_ld(&bar[XB_TOPGEN]) == tg, bar);
            __builtin_amdgcn_fence(__ATOMIC_ACQUIRE, "agent");
            xb_add(&bar[XB_XGEN(b.x)], 1u);
            asm volatile("s_waitcnt vmcnt(0)" ::: "memory");
        } else {
            XB_SPIN(xb_ld(&bar[XB_XGEN(b.x)]) == gen, bar);
            __builtin_amdgcn_fence(__ATOMIC_ACQUIRE, "agent");
            asm volatile("s_waitcnt vmcnt(0)" ::: "memory");
        }
    }
    __syncthreads();
}

#ifndef PHASES
#define PHASES 0x7f
#endif
#ifndef DUP
#define DUP 0
#endif
__global__ void __launch_bounds__(NTHREADS) fwd_megakernel(Params p) {
  cg::grid_group grid = cg::this_grid();
  extern __shared__ __attribute__((aligned(16))) unsigned char smem[];
  unsigned char* ws = p.ws;
  unsigned* bar = (unsigned*)(ws + OFF_BAR);
  volatile LAS unsigned* st = (volatile LAS unsigned*)(LAS unsigned char*)(smem + 143360);
  if (threadIdx.x == 0) { st[0] = 0u; st[1] = 0u; }
#if PHASES & 1
  for (int rep = 0; rep < 1 + ((DUP >> 0) & 1); ++rep) { phase_prep(p, smem); __syncthreads(); }
#endif
  __syncthreads();
  const XcdBarrier xb = xcd_barrier_post(bar, st);
  xcd_barrier(xb);
  if (p.ws == nullptr) grid.sync();
  quant_weight_rows<2>((const bf16_t*)(ws + OFF_WIN), ws + OFF_WIN8, (float*)(ws + OFF_WSC) + 2048, 2560);
  quant_weight_rows<2>((const bf16_t*)(ws + OFF_WQ), ws + OFF_WQ8, (float*)(ws + OFF_WSC), 2048);
  quant_weight_rows<2>((const bf16_t*)(ws + OFF_WOUT), ws + OFF_WOUT8, (float*)(ws + OFF_WSC) + 4608, 1024);
  xcd_barrier(xb);
#if PHASES & 2
  for (int rep = 0; rep < 1 + ((DUP >> 1) & 1); ++rep)
  { EpiIn e{(bf16_t*)(ws + OFF_P), (const f32x2*)(ws + OFF_RT), (const float*)(ws + OFF_SAH), (const float*)(ws + OFF_WSC) + 2048}; StaticOrder so; so.init(NTOK, DIN, gridDim.x, blockIdx.x);
    gemm_phase<EpiIn, StaticOrder, true>(smem, (const bf16_t*)(ws + OFF_H8), (const bf16_t*)(ws + OFF_WIN8), DM / 2, so, e, (const float*)(ws + OFF_SAH), (const float*)(ws + OFF_WSC) + 2048); }
#endif
  xcd_barrier(xb);
#if PHASES & 4
  for (int rep = 0; rep < 1 + ((DUP >> 8) & 1); ++rep) attn_phase(p, smem);
  for (int rep = 0; rep < 1 + ((DUP >> 9) & 1); ++rep)
    for (int item = blockIdx.x; item < 512; item += gridDim.x) spatial_item(p, item, smem);
  xcd_barrier(xb);
  for (int rep = 0; rep < 1 + ((DUP >> 10) & 1); ++rep) attn_merge_phase(p);
#endif
  xcd_barrier(xb);
#if PHASES & 8
  for (int rep = 0; rep < 1 + ((DUP >> 3) & 1); ++rep)
  { EpiOut e{p.x, (bf16_t*)(ws + OFF_X1B), (const float*)(ws + OFF_SAM), (const float*)(ws + OFF_WSC) + 4608}; StaticOrder so; so.init(NTOK, DM, gridDim.x, blockIdx.x);
    gemm_phase<EpiOut, StaticOrder, true>(smem, (const bf16_t*)(ws + OFF_MIX8), (const bf16_t*)(ws + OFF_WOUT8), DM / 2, so, e); }
#endif
  xcd_barrier(xb);
#if PHASES & 16
  for (int rep = 0; rep < 1 + ((DUP >> 4) & 1); ++rep) phase_xn(p);
#endif
  xcd_barrier(xb);
#if PHASES & 32
  for (int rep = 0; rep < 1 + ((DUP >> 5) & 1); ++rep)
  { EpiSel e{(unsigned short*)(ws + OFF_SELE), (float*)(ws + OFF_SELG), (const float*)(ws + OFF_RS), &p, 0}; StaticOrder so; so.init(NTOK, 2048, gridDim.x, blockIdx.x);
    OneUnit one;
    for (int i = 0; so.next(i, one.u); ++i) { e.useq = i * (int)gridDim.x + (int)blockIdx.x; gemm_phase<EpiSel, OneUnit, true>(smem, (const bf16_t*)(ws + OFF_X8), (const bf16_t*)(ws + OFF_WQ8), DM / 2, one, e, (const float*)(ws + OFF_SA8), (const float*)(ws + OFF_WSC)); } }
#endif
  xcd_barrier(xb);
#if PHASES & 64
  phase_udot(p, 0);
#if DUP & 4096
  phase_udot(p, 512);
#endif
  xcd_barrier(xb);
  phase_coef(p);
  xcd_barrier(xb);
  phase_vsum(p);
  xcd_barrier(xb);
  phase_final(p);
#endif
}

extern "C" void kernel_launch(void* const* d_in, const int* in_sizes, int n_in, void* d_out, int out_size, void* d_ws, size_t ws_size, hipStream_t stream) {
  static int grid_blocks = 0;
  if (!grid_blocks) {
    if (hipFuncSetAttribute((const void*)fwd_megakernel, hipFuncAttributeMaxDynamicSharedMemorySize, LDS_BYTES) != hipSuccess) { fprintf(stderr, "hipFuncSetAttribute failed\n"); }
    int dev = 0, cus = 0, per_cu = 0;
    (void)hipGetDevice(&dev);
    (void)hipDeviceGetAttribute(&cus, hipDeviceAttributeMultiprocessorCount, dev);
    (void)hipOccupancyMaxActiveBlocksPerMultiprocessor(&per_cu, (const void*)fwd_megakernel, NTHREADS, LDS_BYTES);
    if (per_cu < 1) { fprintf(stderr, "occupancy query says 0 blocks/CU\n"); per_cu = 1; }
    grid_blocks = cus;
  }
  if (ws_size < WS_NEED) { fprintf(stderr, "workspace too small: %zu < %zu\n", ws_size, WS_NEED); return; }
  Params p{};
  p.x = (const float*)d_in[0]; p.norm1_g = (const float*)d_in[1]; p.w_in = (const float*)d_in[2]; p.ln_v_g = (const float*)d_in[3]; p.ln_v_b = (const float*)d_in[4];
  p.w_spatial = (const float*)d_in[5]; p.b_spatial = (const float*)d_in[6]; p.out_norm_a_g = (const float*)d_in[7]; p.out_norm_b_g = (const float*)d_in[8];
  p.w_out = (const float*)d_in[9]; p.norm2_g = (const float*)d_in[10]; p.w_query = (const float*)d_in[11]; p.sub_keys = (const float*)d_in[12];
  p.expert_u = (const float*)d_in[13]; p.expert_v = (const float*)d_in[14]; p.final_norm_g = (const float*)d_in[15];
  p.out = (float*)d_out; p.ws = (unsigned char*)d_ws;
  void* args[] = {&p};
  if (hipMemsetAsync((unsigned char*)d_ws + OFF_BAR, 0, XCD_BAR_WORDS * sizeof(unsigned), stream) != hipSuccess) fprintf(stderr, "barrier memset failed\n");
  hipError_t e = hipLaunchCooperativeKernel((void*)fwd_megakernel, dim3(grid_blocks), dim3(NTHREADS), args, LDS_BYTES, stream);
  if (e != hipSuccess) fprintf(stderr, "cooperative launch failed: %s (grid %d)\n", hipGetErrorString(e), grid_blocks);
}
```
